# Optimizing an MI355X kernel written in HIP

```python
import jax, jax.numpy as jnp
from jax import lax
import numpy as np

D_MODEL = 1024
BATCH = 4
SEQ = 8192
DEPTH = 1
DEC_BATCH = 32
DEC_SEQ = 64
PAST_LEN = 2048

CHUNK = 64
D_PLE = 256
D_A = 1024
CONV_W = 3
H_B = 8
K_B = 128
V_B = 128
D_B = H_B * V_B
SPLIT_SIZES = (D_A, D_A, D_A, D_A, H_B * K_B, H_B * K_B, D_B, D_B, D_MODEL, D_MODEL)
N_IN = 4 * D_A + 2 * H_B * K_B + 2 * D_B + 2 * D_MODEL
EPS = 1e-6
QK_SCALE = K_B ** -0.5

kernel_name = 'hybrid_shortconv_hgrn2_stream_step'


def rms_norm(x, g):
    xf = x.astype(jnp.float32)
    y = xf * lax.rsqrt(jnp.mean(xf * xf, axis=-1, keepdims=True) + EPS) * g.astype(jnp.float32)
    return y.astype(x.dtype)


def split_cols(z):
    out, off = [], 0
    for s in SPLIT_SIZES:
        out.append(z[..., off:off + s])
        off += s
    return out


def causal_conv3(u_ext, w):
    T = u_ext.shape[1] - (CONV_W - 1)
    out = w[0] * u_ext[:, 0:T]
    for j in range(1, CONV_W):
        out = out + w[j] * u_ext[:, j:j + T]
    return out


def hgrn2_block(S, q, k, v, logf):
    L = q.shape[1]
    b = jnp.cumsum(logf, axis=1)
    ref = b[:, (L - 1) // 2][:, None]
    qe = q * jnp.exp(b - ref)
    ke = k * jnp.exp(ref - b)
    causal = jnp.tril(jnp.ones((L, L), dtype=bool))
    att = jnp.where(causal, jnp.einsum('bthk,bshk->bhts', qe, ke), 0.0)
    o = jnp.einsum('bhts,bshv->bthv', att, v) + jnp.einsum('bthk,bhkv->bthv', q * jnp.exp(b), S)
    b_last = b[:, -1]
    S_new = jnp.exp(b_last)[..., None] * S + jnp.einsum('bshk,bshv->bhkv', k * jnp.exp(b_last[:, None] - b), v)
    return S_new, o


def hgrn2_scan(S0, q, k, v, logf):
    B, T = q.shape[0], q.shape[1]
    if T <= CHUNK:
        return hgrn2_block(S0, q, k, v, logf)
    n = T // CHUNK

    def to_chunks(a):
        return jnp.moveaxis(a.reshape((B, n, CHUNK) + a.shape[2:]), 1, 0)

    def step(S, xs):
        return hgrn2_block(S, xs[0], xs[1], xs[2], xs[3])

    S_fin, o = lax.scan(step, S0, (to_chunks(q), to_chunks(k), to_chunks(v), to_chunks(logf)))
    o = jnp.moveaxis(o, 0, 1).reshape(B, T, H_B, V_B)
    return S_fin, o


def encoder_layer(x, p, conv_hist, S0, lb, w_in, conv_w, g_pre, g_onorm, w_a_out, w_b_out, w_o,
                  g_post, g_ple, w_ple_gate, w_ple_proj):
    B, T = x.shape[0], x.shape[1]
    h = rms_norm(x, g_pre)
    proj = jnp.einsum('btd,dn->btn', h, w_in)
    vA, bA, cA, zA, q, f, iv, zB, gA, gB = split_cols(proj)
    u = cA * vA
    u_ext = jnp.concatenate([conv_hist.astype(u.dtype), u], axis=1)
    conv = causal_conv3(u_ext, conv_w)
    yA = jnp.einsum('btc,cd->btd', jax.nn.silu(zA) * bA * conv, w_a_out)
    new_conv = u_ext[:, -(CONV_W - 1):]
    fg = lb + (1.0 - lb) * jax.nn.sigmoid(f.astype(jnp.float32))
    logf = jnp.log(fg).reshape(B, T, H_B, K_B)
    kk = (1.0 - fg).reshape(B, T, H_B, K_B)
    qq = (jax.nn.silu(q.astype(jnp.float32)) * QK_SCALE).reshape(B, T, H_B, K_B)
    vv = iv.astype(jnp.float32).reshape(B, T, H_B, V_B)
    S_new, o = hgrn2_scan(S0.astype(jnp.float32), qq, kk, vv, logf)
    o = o * lax.rsqrt(jnp.mean(o * o, axis=-1, keepdims=True) + EPS)
    o = (o.reshape(B, T, D_B) * g_onorm.astype(jnp.float32)).astype(x.dtype)
    yB = jnp.einsum('btc,cd->btd', o * jax.nn.silu(zB), w_b_out)
    merged = jax.nn.sigmoid(gA) * yA + jax.nn.sigmoid(gB) * yB
    out = jnp.einsum('btd,de->bte', merged, w_o)
    x = x + rms_norm(out, g_post)
    gate = jax.nn.sigmoid(jnp.einsum('btd,de->bte', rms_norm(x, g_ple), w_ple_gate))
    x = x + jnp.einsum('btp,pd->btd', p.astype(x.dtype), w_ple_proj) * gate
    return x, new_conv, S_new


def setup_inputs(seed: int = 0) -> dict:
    key = jax.random.key(seed)
    ks = jax.random.split(key, 20)
    nrm = jax.random.normal
    f32 = jnp.float32
    return {
        'x_prompt': nrm(ks[0], (BATCH, SEQ, D_MODEL), f32),
        'x_sample': nrm(ks[1], (DEC_BATCH, DEC_SEQ, D_MODEL), f32),
        'state_conv': nrm(ks[2], (DEPTH, DEC_BATCH, CONV_W - 1, D_A), f32),
        'state_hgrn': 0.5 * nrm(ks[3], (DEPTH, DEC_BATCH, H_B, K_B, V_B), f32),
        'p_prompt': nrm(ks[4], (DEPTH, BATCH, SEQ, D_PLE), f32),
        'p_sample': nrm(ks[5], (DEPTH, DEC_BATCH, DEC_SEQ, D_PLE), f32),
        'w_in': nrm(ks[6], (DEPTH, D_MODEL, N_IN), f32) * D_MODEL ** -0.5,
        'conv_w': nrm(ks[7], (DEPTH, CONV_W, D_A), f32) * CONV_W ** -0.5,
        'lb_raw': 0.1 * nrm(ks[8], (DEPTH + 1, H_B * K_B), f32),
        'g_pre': 1.0 + 0.05 * nrm(ks[9], (DEPTH, D_MODEL), f32),
        'g_onorm': 1.0 + 0.05 * nrm(ks[10], (DEPTH, D_B), f32),
        'w_a_out': nrm(ks[11], (DEPTH, D_A, D_MODEL), f32) * D_A ** -0.5,
        'w_b_out': nrm(ks[12], (DEPTH, D_B, D_MODEL), f32) * D_B ** -0.5,
        'w_o': nrm(ks[13], (DEPTH, D_MODEL, D_MODEL), f32) * D_MODEL ** -0.5,
        'g_post': 1.0 + 0.05 * nrm(ks[14], (DEPTH, D_MODEL), f32),
        'g_ple': 1.0 + 0.05 * nrm(ks[15], (DEPTH, D_MODEL), f32),
        'w_ple_gate': nrm(ks[16], (DEPTH, D_MODEL, D_MODEL), f32) * D_MODEL ** -0.5,
        'w_ple_proj': nrm(ks[17], (DEPTH, D_PLE, D_MODEL), f32) * D_PLE ** -0.5,
    }


def reference(x_prompt, x_sample, state_conv, state_hgrn, p_prompt, p_sample, w_in, conv_w, lb_raw,
              g_pre, g_onorm, w_a_out, w_b_out, w_o, g_post, g_ple, w_ple_gate, w_ple_proj):
    lbs = jnp.cumsum(jax.nn.softmax(lb_raw.astype(jnp.float32), axis=0), axis=0)
    xp, xs = x_prompt, x_sample
    conv_p, hgrn_p, conv_s, hgrn_s = [], [], [], []
    for i in range(DEPTH):
        layer_w = (w_in[i], conv_w[i], g_pre[i], g_onorm[i], w_a_out[i], w_b_out[i], w_o[i],
                   g_post[i], g_ple[i], w_ple_gate[i], w_ple_proj[i])
        zero_conv = jnp.zeros((xp.shape[0], CONV_W - 1, D_A), xp.dtype)
        zero_S = jnp.zeros((xp.shape[0], H_B, K_B, V_B), jnp.float32)
        xp, cp, sp = encoder_layer(xp, p_prompt[i], zero_conv, zero_S, lbs[i], *layer_w)
        xs, cs, ss = encoder_layer(xs, p_sample[i], state_conv[i], state_hgrn[i], lbs[i], *layer_w)
        conv_p.append(cp)
        hgrn_p.append(sp)
        conv_s.append(cs)
        hgrn_s.append(ss)
    new_conv_prompt = jnp.stack(conv_p)
    new_hgrn_prompt = jnp.stack(hgrn_p)
    new_conv_sample = jnp.stack(conv_s)
    new_hgrn_sample = jnp.stack(hgrn_s)
    return (xp, xs, new_conv_prompt, new_hgrn_prompt, new_conv_sample, new_hgrn_sample)
```

```cpp
#include <hip/hip_runtime.h>
#include <cstdio>
#include <cstdint>
#include <cstddef>

#define LAS __attribute__((address_space(3)))
typedef unsigned short bf16_t;
typedef short bf16x8 __attribute__((ext_vector_type(8)));
typedef short s16x4 __attribute__((ext_vector_type(4)));
typedef float f32x4 __attribute__((ext_vector_type(4)));
typedef float f32x16 __attribute__((ext_vector_type(16)));
typedef unsigned u32x4 __attribute__((ext_vector_type(4)));
typedef unsigned u32x2 __attribute__((ext_vector_type(2)));

constexpr int M_TOK = 34816;
constexpr int MP = 32768;
constexpr int DM = 1024;
constexpr int NIN = 10240;
constexpr int DPLE = 256;
constexpr float EPS = 1e-6f;
constexpr float QK_SCALE = 0.08838834764831845f;
constexpr int NCHUNK = M_TOK / 64;
constexpr int NCHUNK_P = MP / 64;

typedef float f32x2_t __attribute__((ext_vector_type(2))); typedef __bf16 bf16x2_t __attribute__((ext_vector_type(2)));
__device__ __forceinline__ unsigned cvt_pk_bf16(float lo, float hi) { f32x2_t v = {lo, hi}; bf16x2_t b = __builtin_convertvector(v, bf16x2_t); return __builtin_bit_cast(unsigned, b); }
__device__ __forceinline__ float bf2f(unsigned short b) { return __uint_as_float((unsigned)b << 16); }
__device__ __forceinline__ float bflo(unsigned w) { return __uint_as_float(w << 16); }
__device__ __forceinline__ float bfhi(unsigned w) { return __uint_as_float(w & 0xffff0000u); }
__device__ __forceinline__ unsigned short f2bf(float f) { return (unsigned short)(cvt_pk_bf16(f, 0.0f) & 0xffffu); }
__device__ __forceinline__ float sigmoid_f(float x) { return __builtin_amdgcn_rcpf(1.0f + __expf(-x)); }
__device__ __forceinline__ float silu_f(float x) { return x * sigmoid_f(x); }
__device__ __forceinline__ unsigned short f2h(float f) { _Float16 h = (_Float16)f; return __builtin_bit_cast(unsigned short, h); }
__device__ __forceinline__ float h2f(unsigned short u) { return (float)__builtin_bit_cast(_Float16, u); }
__device__ __forceinline__ float wave_sum(float v) {
#pragma unroll
    for (int o = 1; o < 64; o <<= 1) v += __shfl_xor(v, o);
    return v;
}
#define LDS_WAIT() asm volatile("s_waitcnt lgkmcnt(0)" ::: "memory")
__device__ __forceinline__ int launder(int x) { asm volatile("" : "+v"(x)); return x; }

namespace pg8 {
constexpr int BM = 256, BK = 64, HALF = 128, HTB = HALF * BK * 2, STAGE_BYTES = 8 * HTB, NXCD = 8, WGM = 8;
__host__ __device__ __forceinline__ int lds_byte(int r, int c) { const int st = (r >> 4) * 2 + (c >> 5), rr = r & 15, cc = c & 31, ob = rr * 64 + cc * 2; return st * 1024 + (ob ^ (((ob >> 9) & 1) << 5)); }
__host__ __device__ __forceinline__ void stage_rc(int b, int& R, int& C) { const int st = b / 1024, sb = b % 1024, swz = sb ^ (((sb >> 9) & 1) << 5); R = (st >> 1) * 16 + swz / 64; C = (st & 1) * 32 + (swz % 64) / 2; }
__host__ __device__ __forceinline__ int perm32(int rho) { const int n = rho >> 4, i = rho & 15; return 8 * (i >> 2) + 4 * n + (i & 3); }

struct Unit { int pm, pn; };
struct Gemm { const bf16_t* A; const bf16_t* A2; const bf16_t* Bt; int M, N, K, lda, ldb, kseg; };

struct StaticOrder {
    int nM, nN, nwg, G, c;
    __host__ __device__ void init(int M, int N, int G_, int c_) { nM = M / BM; nN = N / BM; nwg = nM * nN; G = G_; c = c_; }
    __host__ __device__ bool next(int i, Unit& u) const {
        const long L = (long)i * G + c; if (L >= nwg) return false;
        int wgid = (int)L; { const int q = nwg / NXCD, r = nwg % NXCD, xcd = wgid % NXCD, off = wgid / NXCD; wgid = (xcd < r ? xcd * (q + 1) : r * (q + 1) + (xcd - r) * q) + off; }
        const int nig = WGM * nN, gid = wgid / nig, fm = gid * WGM, gsz = (nM - fm) < WGM ? (nM - fm) : WGM;
        u.pm = fm + ((wgid % nig) % gsz); u.pn = (wgid % nig) / gsz; return true;
    }
};

template <class Epi, bool ALIGN_EPI, bool SP2>
__device__ __forceinline__ void gemm_phase(LAS unsigned char* lds, const Gemm g, const StaticOrder& S, const Epi& E) {
    const int tid = launder((int)threadIdx.x), wid = __builtin_amdgcn_readfirstlane(tid >> 6), lane = tid & 63, wr = wid >> 2, wc = wid & 3, fr = lane & 15, fq = lane >> 4;
    const int K = g.K, nt = K / BK;
    unsigned voffA[2], voffB[2];
#pragma unroll
    for (int i = 0; i < 2; ++i) { int R, C; stage_rc(tid * 16 + i * 8192, R, C); const int Rb = (R & ~31) + perm32(R & 31);
        voffA[i] = (unsigned)(R * g.lda + C) * 2u; voffB[i] = (unsigned)(Rb * g.ldb + C) * 2u; }
    const size_t kstep = (size_t)(BK * 2);
    const size_t hstepA = (size_t)HALF * g.lda * 2, hstepB = (size_t)HALF * g.ldb * 2;
    const size_t tstepA = 2 * hstepA, tstepB = 2 * hstepB;
    const ptrdiff_t segd = g.A2 ? (((const char*)g.A2 - (const char*)g.A) - (ptrdiff_t)g.kseg * (ptrdiff_t)kstep) : (ptrdiff_t)0;
    const int kseg = g.A2 ? g.kseg : (nt + 8);
    const unsigned ldsw = (unsigned)wid * 1024u;
    const int aoff = lds_byte(wr * 64 + fr, fq * 8), boff = lds_byte(wc * 32 + fr, fq * 8);
#define PG8_SA(b, h) (((b) * 2 + (h)) * HTB)
#define PG8_SB(b, h) ((4 + (b) * 2 + (h)) * HTB)
#define PG8_STAGE(bufoff, gbase, voff) do { _Pragma("unroll") for (int _i = 0; _i < 2; ++_i) \
        __builtin_amdgcn_global_load_lds((const unsigned*)((const char*)(gbase) + (voff)[_i]), (LAS unsigned*)(lds + (bufoff) + ldsw + _i * 8192), 16, 0, 0); } while (0)
#define PG8_LDA(dst, b, h) do { _Pragma("unroll") for (int m = 0; m < 4; ++m) _Pragma("unroll") for (int k = 0; k < 2; ++k) dst[m][k] = *(const LAS bf16x8*)(lds + PG8_SA(b, h) + aoff + m * 2048 + k * 1024); } while (0)
#define PG8_LDB(dst, b, h) do { _Pragma("unroll") for (int n = 0; n < 2; ++n) _Pragma("unroll") for (int k = 0; k < 2; ++k) dst[n][k] = *(const LAS bf16x8*)(lds + PG8_SB(b, h) + boff + n * 2048 + k * 1024); } while (0)
#define PG8_MMA(ai, bj, At, Bt) do { __builtin_amdgcn_s_setprio(1); _Pragma("unroll") for (int m = 0; m < 4; ++m) _Pragma("unroll") for (int n = 0; n < 2; ++n) _Pragma("unroll") for (int k = 0; k < 2; ++k) \
        acc[ai][bj][m][n] = __builtin_amdgcn_mfma_f32_16x16x32_bf16(Bt[n][k], At[m][k], acc[ai][bj][m][n], 0, 0, 0); __builtin_amdgcn_s_setprio(0); } while (0)
#define PG8_WAIT_V(n) asm volatile("s_waitcnt vmcnt(" #n ")" ::: "memory")
#define PG8_WAIT_L(n) asm volatile("s_waitcnt lgkmcnt(" #n ")" ::: "memory")
#define PG8_BAR __builtin_amdgcn_s_barrier()
#define PG8_SCHED __builtin_amdgcn_sched_barrier(0)
    Unit cur, nxt; int ui = 0;
    if (!S.next(0, cur)) return;
    f32x4 acc[2][2][4][2];
#pragma unroll
    for (int a = 0; a < 2; ++a)
#pragma unroll
        for (int b = 0; b < 2; ++b)
#pragma unroll
            for (int m = 0; m < 4; ++m)
#pragma unroll
                for (int n = 0; n < 2; ++n) acc[a][b][m][n] = (f32x4){0.f, 0.f, 0.f, 0.f};
    bf16x8 At[4][2], B0[2][2], B1[2][2];
    const char* cA = (const char*)g.A + (size_t)cur.pm * tstepA; const char* cB = (const char*)g.Bt + (size_t)cur.pn * tstepB;
    if constexpr (SP2) {
        PG8_STAGE(PG8_SB(0, 0), cB, voffB); PG8_STAGE(PG8_SB(0, 1), cB + hstepB, voffB); PG8_STAGE(PG8_SA(0, 0), cA, voffA); PG8_STAGE(PG8_SA(0, 1), cA + hstepA, voffA);
        if (wr == 1) PG8_BAR;
        PG8_WAIT_V(2); PG8_BAR;
        PG8_STAGE(PG8_SB(1, 0), cB + kstep, voffB); PG8_STAGE(PG8_SA(1, 0), cA + kstep, voffA); PG8_STAGE(PG8_SB(1, 1), cB + hstepB + kstep, voffB);
        PG8_WAIT_V(6); PG8_BAR;
    } else {
        PG8_STAGE(PG8_SB(0, 0), cB, voffB); PG8_STAGE(PG8_SA(0, 0), cA, voffA); PG8_STAGE(PG8_SB(0, 1), cB + hstepB, voffB); PG8_STAGE(PG8_SA(0, 1), cA + hstepA, voffA);
        if (wr == 1) PG8_BAR;
        PG8_WAIT_V(4); PG8_BAR;
        PG8_STAGE(PG8_SB(1, 0), cB + kstep, voffB); PG8_STAGE(PG8_SA(1, 0), cA + kstep, voffA); PG8_STAGE(PG8_SB(1, 1), cB + hstepB + kstep, voffB);
        PG8_WAIT_V(6); PG8_BAR;
    }
    for (;;) {
        const bool has_next = S.next(ui + 1, nxt);
        const char* nA = has_next ? (const char*)g.A + (size_t)nxt.pm * tstepA : cA; const char* nB = has_next ? (const char*)g.Bt + (size_t)nxt.pn * tstepB : cB;
#pragma nounroll
        for (int t = 0; t < nt; t += 2) {
            if constexpr (Epi::HAS_MID) { if (t == kseg) E.mid(acc, cur, wr, wc, fr, fq); }
            const bool last = (t == nt - 2);
            const char* a1 = cA + (size_t)(t + 1) * kstep + ((t + 1) >= kseg ? segd : (ptrdiff_t)0);
            const char* a2 = last ? nA : cA + (size_t)(t + 2) * kstep + ((t + 2) >= kseg ? segd : (ptrdiff_t)0);
            const char* b2 = last ? nB : cB + (size_t)(t + 2) * kstep;
            const char* a3 = a2 + kstep; const char* b3 = b2 + kstep;
            if constexpr (SP2) {
            PG8_LDB(B0, 0, 0); PG8_LDB(B1, 0, 1); PG8_SCHED; PG8_LDA(At, 0, 0); PG8_STAGE(PG8_SA(1, 1), a1 + hstepA, voffA);
            PG8_WAIT_V(8); PG8_WAIT_L(0); PG8_BAR; PG8_MMA(0, 0, At, B0); PG8_MMA(0, 1, At, B1); PG8_BAR; PG8_SCHED;
            PG8_LDA(At, 0, 1); PG8_STAGE(PG8_SB(0, 0), b2, voffB); PG8_STAGE(PG8_SB(0, 1), b2 + hstepB, voffB); PG8_STAGE(PG8_SA(0, 0), a2, voffA);
            PG8_WAIT_V(8); PG8_WAIT_L(0); PG8_BAR; PG8_MMA(1, 0, At, B0); PG8_MMA(1, 1, At, B1); PG8_BAR; PG8_SCHED;
            PG8_LDB(B0, 1, 0); PG8_LDB(B1, 1, 1); PG8_SCHED; PG8_LDA(At, 1, 0); PG8_STAGE(PG8_SA(0, 1), a2 + hstepA, voffA);
            PG8_WAIT_V(8); PG8_WAIT_L(0); PG8_BAR; PG8_MMA(0, 0, At, B0); PG8_MMA(0, 1, At, B1); PG8_BAR; PG8_SCHED;
            PG8_LDA(At, 1, 1); PG8_STAGE(PG8_SB(1, 0), b3, voffB); PG8_STAGE(PG8_SB(1, 1), b3 + hstepB, voffB); PG8_STAGE(PG8_SA(1, 0), a3, voffA);
            PG8_WAIT_V(8); PG8_WAIT_L(0); PG8_BAR; PG8_MMA(1, 0, At, B0); PG8_MMA(1, 1, At, B1); PG8_BAR; PG8_SCHED;
            } else {
            PG8_LDB(B0, 0, 0); PG8_SCHED; PG8_LDA(At, 0, 0); PG8_STAGE(PG8_SA(1, 1), a1 + hstepA, voffA);
            PG8_WAIT_L(8); PG8_BAR; PG8_WAIT_L(0); PG8_MMA(0, 0, At, B0); PG8_BAR; PG8_SCHED;
            PG8_LDB(B1, 0, 1); PG8_STAGE(PG8_SB(0, 0), b2, voffB);
            PG8_BAR; PG8_WAIT_L(0); PG8_MMA(0, 1, At, B1); PG8_BAR;
            PG8_LDA(At, 0, 1); PG8_STAGE(PG8_SA(0, 0), a2, voffA);
            PG8_BAR; PG8_WAIT_L(0); PG8_MMA(1, 0, At, B0); PG8_BAR; PG8_SCHED;
            PG8_STAGE(PG8_SB(0, 1), b2 + hstepB, voffB);
            PG8_WAIT_V(6); PG8_BAR; PG8_MMA(1, 1, At, B1); PG8_BAR;
            PG8_LDB(B0, 1, 0); PG8_SCHED; PG8_LDA(At, 1, 0); PG8_STAGE(PG8_SA(0, 1), a2 + hstepA, voffA);
            PG8_WAIT_L(8); PG8_BAR; PG8_WAIT_L(0); PG8_MMA(0, 0, At, B0); PG8_BAR; PG8_SCHED;
            PG8_LDB(B1, 1, 1); PG8_STAGE(PG8_SB(1, 0), b3, voffB);
            PG8_BAR; PG8_WAIT_L(0); PG8_MMA(0, 1, At, B1); PG8_BAR;
            PG8_LDA(At, 1, 1); PG8_STAGE(PG8_SA(1, 0), a3, voffA);
            PG8_BAR; PG8_WAIT_L(0); PG8_MMA(1, 0, At, B0); PG8_BAR; PG8_SCHED;
            PG8_STAGE(PG8_SB(1, 1), b3 + hstepB, voffB);
            PG8_WAIT_V(6); PG8_BAR; PG8_MMA(1, 1, At, B1); PG8_BAR;
            }
        }
        if constexpr (ALIGN_EPI) { if (wr == 0) PG8_BAR; }
        E(acc, cur, wr, wc, fr, fq);
        if (!has_next) break;
#pragma unroll
        for (int a = 0; a < 2; ++a)
#pragma unroll
            for (int b = 0; b < 2; ++b)
#pragma unroll
                for (int m = 0; m < 4; ++m)
#pragma unroll
                    for (int n = 0; n < 2; ++n) acc[a][b][m][n] = (f32x4){0.f, 0.f, 0.f, 0.f};
        cur = nxt; cA = nA; cB = nB; ++ui;
        if constexpr (ALIGN_EPI) { if (wr == 1) PG8_BAR; }
    }
    PG8_WAIT_V(0);
    if constexpr (!ALIGN_EPI) { if (wr == 0) PG8_BAR; }
    PG8_BAR;
#undef PG8_SA
#undef PG8_SB
#undef PG8_STAGE
#undef PG8_LDA
#undef PG8_LDB
#undef PG8_MMA
#undef PG8_WAIT_V
#undef PG8_WAIT_L
#undef PG8_BAR
#undef PG8_SCHED
}
}

__device__ __forceinline__ u32x4 pack8(const f32x4 a, const f32x4 b) { u32x4 w; w.x = cvt_pk_bf16(a[0], a[1]); w.y = cvt_pk_bf16(a[2], a[3]); w.z = cvt_pk_bf16(b[0], b[1]); w.w = cvt_pk_bf16(b[2], b[3]); return w; }
__device__ __forceinline__ void unpack8(const u32x4 w, f32x4& a, f32x4& b) { a = (f32x4){bflo(w.x), bfhi(w.x), bflo(w.y), bfhi(w.y)}; b = (f32x4){bflo(w.z), bfhi(w.z), bflo(w.w), bfhi(w.w)}; }

struct Epi1 {
    static constexpr bool HAS_MID = false;
    const float* rinv; const float* lbv;
    bf16_t *UF, *GA, *Q, *V, *SZ, *SGA, *SGB; unsigned short* LFH; float* conv_p; float* conv_s; const float* convw; LAS unsigned char* ldsx;
    __device__ __forceinline__ void operator()(const f32x4 (&acc)[2][2][4][2], const pg8::Unit& u, int wr, int wc, int fr, int fq) const {
        const int row0 = launder(u.pm * 256 + wr * 64 + fr);
        float rv[2][4];
#pragma unroll
        for (int ai = 0; ai < 2; ++ai)
#pragma unroll
            for (int m = 0; m < 4; ++m) rv[ai][m] = rinv[row0 + ai * 128 + m * 16];
        if (u.pn < 16) {
            const int c4 = launder(u.pn * 64 + wc * 16 + 4 * fq);
            const f32x4 w0 = *(const f32x4*)(convw + c4), w1 = *(const f32x4*)(convw + DM + c4), w2 = *(const f32x4*)(convw + 2 * DM + c4);
            LAS unsigned short* wl = (LAS unsigned short*)(ldsx + (wr * 4 + wc) * 2048);
#pragma unroll
            for (int ai = 0; ai < 2; ++ai) {
                f32x4 uu[4], gg[4];
#pragma unroll
                for (int m = 0; m < 4; ++m) {
                    const int row = row0 + ai * 128 + m * 16; const float r = rv[ai][m]; const float r2 = r * r;
                    uu[m] = acc[ai][0][m][0] * acc[ai][0][m][1] * r2;
#pragma unroll
                    for (int e = 0; e < 4; ++e) gg[m][e] = silu_f(acc[ai][1][m][1][e] * r) * (acc[ai][1][m][0][e] * r);
                    float* cdst = nullptr;
                    if (row < MP) { const int t = row & 8191; if (t >= 8190) cdst = conv_p + ((size_t)((row >> 13) * 2 + (t - 8190))) * DM + c4; }
                    else { const int rs = row - MP; const int t = rs & 63; if (t >= 62) cdst = conv_s + ((size_t)((rs >> 6) * 2 + (t - 62))) * DM + c4; }
                    if (cdst) *(f32x4*)cdst = uu[m];
                    u32x2 w; w.x = cvt_pk_bf16(uu[m][0], uu[m][1]); w.y = cvt_pk_bf16(uu[m][2], uu[m][3]);
                    *(LAS u32x2*)(wl + (16 * m + fr) * 16 + 4 * fq) = w;
                    if ((m == 0 && fr < 2) || (m == 3 && fr >= 14)) { const int slot = (m == 0) ? fr : (fr - 12);
                        *(u32x2*)(UF + ((size_t)(row >> 6) * 4 + slot) * DM + c4) = w; }
                }
                LDS_WAIT(); asm volatile("" ::: "memory");
#pragma unroll
                for (int m = 0; m < 4; ++m) {
                    const int row = row0 + ai * 128 + m * 16; const int lr = 16 * m + fr;
                    f32x4 res = gg[m];
                    if (lr >= 2) {
                        const u32x2 a1 = *(const LAS u32x2*)(wl + (lr - 1) * 16 + 4 * fq), a2 = *(const LAS u32x2*)(wl + (lr - 2) * 16 + 4 * fq);
                        const f32x4 um1 = (f32x4){bflo(a1.x), bfhi(a1.x), bflo(a1.y), bfhi(a1.y)}, um2 = (f32x4){bflo(a2.x), bfhi(a2.x), bflo(a2.y), bfhi(a2.y)};
                        res = gg[m] * (w0 * um2 + w1 * um1 + w2 * uu[m]);
                    }
                    u32x2 w; w.x = cvt_pk_bf16(res[0], res[1]); w.y = cvt_pk_bf16(res[2], res[3]);
                    *(u32x2*)(GA + (size_t)row * DM + c4) = w;
                }
                LDS_WAIT(); asm volatile("" ::: "memory");
            }
            return;
        }
        const int type = 2 + ((u.pn - 16) >> 3);
        const int ch0 = launder(((u.pn - 16) & 7) * 128 + wc * 32 + 8 * fq);
        if (type == 2) {
            const f32x4 lb0 = *(const f32x4*)(lbv + ch0), lb1 = *(const f32x4*)(lbv + ch0 + 4);
#pragma unroll
            for (int ai = 0; ai < 2; ++ai)
#pragma unroll
                for (int m = 0; m < 4; ++m) {
                    const int row = row0 + ai * 128 + m * 16; const float r = rv[ai][m];
                    f32x4 q0, q1; unsigned short lf[8];
#pragma unroll
                    for (int i = 0; i < 4; ++i) {
                        q0[i] = acc[ai][0][m][0][i] * r; q1[i] = acc[ai][0][m][1][i] * r;
                        const float f0 = lb0[i] + (1.0f - lb0[i]) * sigmoid_f(acc[ai][1][m][0][i] * r), f1 = lb1[i] + (1.0f - lb1[i]) * sigmoid_f(acc[ai][1][m][1][i] * r);
                        lf[i] = f2h(__logf(f0)); lf[4 + i] = f2h(__logf(f1));
                    }
                    *(u32x4*)(Q + (size_t)row * DM + ch0) = pack8(q0, q1);
                    u32x4 w; w.x = (unsigned)lf[0] | ((unsigned)lf[1] << 16); w.y = (unsigned)lf[2] | ((unsigned)lf[3] << 16); w.z = (unsigned)lf[4] | ((unsigned)lf[5] << 16); w.w = (unsigned)lf[6] | ((unsigned)lf[7] << 16);
                    *(u32x4*)(LFH + (size_t)row * DM + ch0) = w;
                }
        } else if (type == 3) {
#pragma unroll
            for (int ai = 0; ai < 2; ++ai)
#pragma unroll
                for (int m = 0; m < 4; ++m) {
                    const int row = row0 + ai * 128 + m * 16; const float r = rv[ai][m];
                    f32x4 z0, z1;
#pragma unroll
                    for (int i = 0; i < 4; ++i) { z0[i] = acc[ai][1][m][0][i] * r; z1[i] = acc[ai][1][m][1][i] * r; }
                    *(u32x4*)(V + (size_t)row * DM + ch0) = pack8(acc[ai][0][m][0] * r, acc[ai][0][m][1] * r);
                    *(u32x4*)(SZ + (size_t)row * DM + ch0) = pack8(z0, z1);
                }
        } else {
#pragma unroll
            for (int ai = 0; ai < 2; ++ai)
#pragma unroll
                for (int m = 0; m < 4; ++m) {
                    const int row = row0 + ai * 128 + m * 16; const float r = rv[ai][m];
                    f32x4 a0, a1, b0, b1;
#pragma unroll
                    for (int i = 0; i < 4; ++i) { a0[i] = sigmoid_f(acc[ai][0][m][0][i] * r); a1[i] = sigmoid_f(acc[ai][0][m][1][i] * r); b0[i] = sigmoid_f(acc[ai][1][m][0][i] * r); b1[i] = sigmoid_f(acc[ai][1][m][1][i] * r); }
                    *(u32x4*)(SGA + (size_t)row * DM + ch0) = pack8(a0, a1);
                    *(u32x4*)(SGB + (size_t)row * DM + ch0) = pack8(b0, b1);
                }
        }
    }
};

struct EpiMerge {
    static constexpr bool HAS_MID = true;
    const bf16_t *SGA, *SGB; bf16_t* MG;
    __device__ __forceinline__ void mid(f32x4 (&acc)[2][2][4][2], const pg8::Unit& u, int wr, int wc, int fr, int fq) const {
        const int row0 = launder(u.pm * 256 + wr * 64 + fr), colb = launder(u.pn * 256 + wc * 32 + 8 * fq);
#pragma unroll
        for (int ai = 0; ai < 2; ++ai) {
            u32x4 la[4][2], lb[4][2];
#pragma unroll
            for (int m = 0; m < 4; ++m)
#pragma unroll
                for (int bj = 0; bj < 2; ++bj) { const size_t off = (size_t)(row0 + ai * 128 + m * 16) * DM + colb + bj * 128;
                    la[m][bj] = __builtin_nontemporal_load((const u32x4*)(SGA + off)); lb[m][bj] = *(const u32x4*)(SGB + off); }
#pragma unroll
            for (int m = 0; m < 4; ++m)
#pragma unroll
                for (int bj = 0; bj < 2; ++bj) {
                    f32x4 a0, a1, b0, b1; unpack8(la[m][bj], a0, a1); unpack8(lb[m][bj], b0, b1);
#pragma unroll
                    for (int i = 0; i < 4; ++i) { acc[ai][bj][m][0][i] *= a0[i] * __builtin_amdgcn_rcpf(b0[i]); acc[ai][bj][m][1][i] *= a1[i] * __builtin_amdgcn_rcpf(b1[i]); }
                }
            asm volatile("" : "+v"(acc[ai][0][0][0]), "+v"(acc[ai][1][3][1]) :: "memory");
        }
    }
    __device__ __forceinline__ void operator()(const f32x4 (&acc)[2][2][4][2], const pg8::Unit& u, int wr, int wc, int fr, int fq) const {
        const int row0 = launder(u.pm * 256 + wr * 64 + fr), colb = launder(u.pn * 256 + wc * 32 + 8 * fq);
#pragma unroll
        for (int ai = 0; ai < 2; ++ai) {
            u32x4 lb[4][2];
#pragma unroll
            for (int m = 0; m < 4; ++m)
#pragma unroll
                for (int bj = 0; bj < 2; ++bj) lb[m][bj] = __builtin_nontemporal_load((const u32x4*)(SGB + (size_t)(row0 + ai * 128 + m * 16) * DM + colb + bj * 128));
#pragma unroll
            for (int m = 0; m < 4; ++m)
#pragma unroll
                for (int bj = 0; bj < 2; ++bj) { const size_t off = (size_t)(row0 + ai * 128 + m * 16) * DM + colb + bj * 128;
                    f32x4 b0, b1; unpack8(lb[m][bj], b0, b1);
                    *(u32x4*)(MG + off) = pack8(acc[ai][bj][m][0] * b0, acc[ai][bj][m][1] * b1); }
            asm volatile("" ::: "memory");
        }
    }
};

struct EpiO {
    static constexpr bool HAS_MID = false;
    bf16_t* OUT; float* SSQ;
    __device__ __forceinline__ void operator()(const f32x4 (&acc)[2][2][4][2], const pg8::Unit& u, int wr, int wc, int fr, int fq) const {
        const int row0 = launder(u.pm * 256 + wr * 64 + fr), colb = launder(u.pn * 256 + wc * 32 + 8 * fq);
#pragma unroll
        for (int ai = 0; ai < 2; ++ai)
#pragma unroll
            for (int m = 0; m < 4; ++m) {
                const int row = row0 + ai * 128 + m * 16; float s = 0.f;
#pragma unroll
                for (int bj = 0; bj < 2; ++bj) {
                    const f32x4 v0 = acc[ai][bj][m][0], v1 = acc[ai][bj][m][1];
                    *(u32x4*)(OUT + (size_t)row * DM + colb + bj * 128) = pack8(v0, v1);
                    s += (v0[0] * v0[0] + v0[1] * v0[1]) + (v0[2] * v0[2] + v0[3] * v0[3]) + (v1[0] * v1[0] + v1[1] * v1[1]) + (v1[2] * v1[2] + v1[3] * v1[3]);
                }
                s += __shfl_xor(s, 16); s += __shfl_xor(s, 32);
                if (fq == 0) SSQ[(size_t)row * 16 + u.pn * 4 + wc] = s;
            }
    }
};

struct EpiPP {
    static constexpr bool HAS_MID = false;
    bf16_t* PP;
    __device__ __forceinline__ void operator()(const f32x4 (&acc)[2][2][4][2], const pg8::Unit& u, int wr, int wc, int fr, int fq) const {
        const int row0 = launder(u.pm * 256 + wr * 64 + fr), colb = launder(u.pn * 256 + wc * 32 + 8 * fq);
#pragma unroll
        for (int ai = 0; ai < 2; ++ai)
#pragma unroll
            for (int m = 0; m < 4; ++m)
#pragma unroll
                for (int bj = 0; bj < 2; ++bj) {
                    const size_t off = (size_t)(row0 + ai * 128 + m * 16) * DM + colb + bj * 128;
                    *(u32x4*)(PP + off) = pack8(acc[ai][bj][m][0], acc[ai][bj][m][1]);
                }
    }
};

struct EpiFinal {
    static constexpr bool HAS_MID = false;
    const float* R1; const float* RS; const bf16_t* PP; const bf16_t* OUT; const float* X; const float* gpost; float* Y;
    __device__ __forceinline__ void operator()(const f32x4 (&acc)[2][2][4][2], const pg8::Unit& u, int wr, int wc, int fr, int fq) const {
        const int row0 = launder(u.pm * 256 + wr * 64 + fr), colb = launder(u.pn * 256 + wc * 32 + 8 * fq);
        f32x4 g[2][2];
#pragma unroll
        for (int bj = 0; bj < 2; ++bj) { g[bj][0] = *(const f32x4*)(gpost + colb + bj * 128); g[bj][1] = *(const f32x4*)(gpost + colb + bj * 128 + 4); }
#pragma unroll
        for (int ai = 0; ai < 2; ++ai)
#pragma unroll
            for (int mp = 0; mp < 2; ++mp) {
                u32x4 lp[2][2], lo[2][2]; f32x4 lx[2][2][2]; float rr[2], rsv[2];
#pragma unroll
                for (int mm = 0; mm < 2; ++mm) { const int row = row0 + ai * 128 + (2 * mp + mm) * 16; rr[mm] = R1[row]; rsv[mm] = RS[row];
#pragma unroll
                    for (int bj = 0; bj < 2; ++bj) { const size_t off = (size_t)row * DM + colb + bj * 128;
                        lp[mm][bj] = __builtin_nontemporal_load((const u32x4*)(PP + off)); lo[mm][bj] = __builtin_nontemporal_load((const u32x4*)(OUT + off));
                        lx[mm][bj][0] = __builtin_nontemporal_load((const f32x4*)(X + off)); lx[mm][bj][1] = __builtin_nontemporal_load((const f32x4*)(X + off + 4)); } }
#pragma unroll
                for (int mm = 0; mm < 2; ++mm) { const int m = 2 * mp + mm; const int row = row0 + ai * 128 + m * 16; const float r = rr[mm], rs = rsv[mm];
#pragma unroll
                    for (int bj = 0; bj < 2; ++bj) { const size_t off = (size_t)row * DM + colb + bj * 128;
                        f32x4 p0, p1, o0, o1; unpack8(lp[mm][bj], p0, p1); unpack8(lo[mm][bj], o0, o1);
                        f32x4 y0 = lx[mm][bj][0] + o0 * rs * g[bj][0], y1 = lx[mm][bj][1] + o1 * rs * g[bj][1];
#pragma unroll
                        for (int i = 0; i < 4; ++i) { y0[i] += p0[i] * sigmoid_f(acc[ai][bj][m][0][i] * r); y1[i] += p1[i] * sigmoid_f(acc[ai][bj][m][1][i] * r); }
                        __builtin_nontemporal_store(y0, (f32x4*)(Y + off)); __builtin_nontemporal_store(y1, (f32x4*)(Y + off + 4)); } }
                asm volatile("" ::: "memory");
            }
    }
};

constexpr size_t MiB = 1u << 20;
constexpr size_t BUF = (size_t)M_TOK * DM * 2;
constexpr size_t WS_GA = 0, WS_Q = 68 * MiB, WS_LFH = 136 * MiB, WS_V = 204 * MiB, WS_SZ = 272 * MiB, WS_U = 340 * MiB, WS_XB = 408 * MiB, WS_BTIN = 476 * MiB;
constexpr size_t WS_BTAB = 496 * MiB, WS_BTO = 500 * MiB, WS_BTG = 502 * MiB, WS_BTP = 504 * MiB;
constexpr size_t WS_RINV = 505 * MiB, WS_R1 = WS_RINV + 256 * 1024, WS_LBV = WS_R1 + 256 * 1024, WS_DEC = 506 * MiB, WS_SSQ = 509 * MiB, WS_END = 512 * MiB;
constexpr size_t WS_SSQ2 = WS_DEC + 1 * MiB;
constexpr size_t WS_BAR = 511 * MiB + 512 * 1024;
constexpr size_t WS_DST = WS_U;
constexpr size_t WS_MG = WS_U;
constexpr size_t WS_OUT = WS_Q;
constexpr size_t WS_X1B = WS_V;
constexpr size_t WS_PB = WS_BTIN;
constexpr size_t WS_PP = WS_XB;
static_assert(BUF == 68 * MiB, "buffer size");
static_assert(WS_DEC + (size_t)NCHUNK * 8 * 128 * 4 <= WS_SSQ && WS_SSQ + (size_t)M_TOK * 16 * 4 <= WS_END, "ws map");
constexpr size_t O_Y = 0, O_CONVP = (size_t)M_TOK * DM, O_HP = O_CONVP + 4 * 2 * 1024, O_CONVS = O_HP + (size_t)4 * 8 * 128 * 128, O_HS = O_CONVS + 32 * 2 * 1024;
constexpr size_t O_TOTAL = O_HS + (size_t)32 * 8 * 128 * 128;

struct Args { const float* in[18]; float* out; unsigned char* ws; };

__device__ __forceinline__ void p0_transpose(const float* W, int N, const float* scale, bf16_t* dst, int ldk, int koff, int dstrow0, int k0, int n0, LAS float* scr, int lane, bool amap = false) {
    float wv[32], sv[32];
#pragma unroll
    for (int i = 0; i < 32; ++i) { const int kk = 2 * i + (lane >> 5); wv[i] = __builtin_nontemporal_load(W + (size_t)(k0 + kk) * N + n0 + (lane & 31)); sv[i] = scale ? scale[k0 + kk] : 1.0f; }
#pragma unroll
    for (int i = 0; i < 32; ++i) { const int kk = 2 * i + (lane >> 5); scr[kk * 33 + (lane & 31)] = wv[i] * sv[i]; }
    LDS_WAIT(); asm volatile("" ::: "memory");
    const int c = lane & 7;
#pragma unroll
    for (int j = 0; j < 4; ++j) { const int n = (lane >> 3) + 8 * j; const LAS float* s = scr + (8 * c) * 33 + n;
        u32x4 o; o.x = cvt_pk_bf16(s[0 * 33], s[1 * 33]); o.y = cvt_pk_bf16(s[2 * 33], s[3 * 33]); o.z = cvt_pk_bf16(s[4 * 33], s[5 * 33]); o.w = cvt_pk_bf16(s[6 * 33], s[7 * 33]);
        const int nr = amap ? (32 * (n >> 4) + 8 * ((n >> 2) & 3) + (n & 3)) : n;
        *(u32x4*)(dst + (size_t)(dstrow0 + nr) * ldk + koff + k0 + 8 * c) = o; }
    LDS_WAIT(); asm volatile("" ::: "memory");
}

#define VT_GRP(v_, g_) ((((g_) ^ (((v_) >> 3) & 7)) << 3))
constexpr int NSC = 4;
constexpr int NSU = (NCHUNK_P / NSC) * 8;
constexpr int NSMP = (NCHUNK - NCHUNK_P) * 8;
__device__ __forceinline__ void step_map(int j, int nps, int bid, int G, int& un, int& su, bool& first, bool& last) {
    if (j < nps) { const int i = j / NSC, c = j % NSC; su = bid + G * i; un = (((su >> 3) * NSC + c) << 3) + (su & 7); first = (c == 0); last = (c == NSC - 1); }
    else { su = -1; un = NCHUNK_P * 8 + bid + G * (j - nps); first = true; last = true; }
}
__device__ __forceinline__ void p2b_scan(const LAS unsigned short* LF, LAS unsigned short* kd, LAS float* decs, float* decg, bool first, bool last, float& dprod, int tid) {
    const int k = tid & 127, tq = tid >> 7;
    float lfv[16];
#pragma unroll
    for (int j = 0; j < 16; ++j) lfv[j] = h2f(LF[(tq * 16 + j) * 136 + k]);
    float r = 0.f;
    for (int q2 = tq + 1; q2 < 4; ++q2) {
#pragma unroll
        for (int j = 0; j < 16; ++j) r += h2f(LF[(q2 * 16 + j) * 136 + k]);
    }
    float kv[16];
    float er = __expf(r);
#pragma unroll
    for (int j = 15; j >= 0; --j) { const float fj = __expf(lfv[j]); kv[j] = (1.0f - fj) * er; er *= fj; r += lfv[j]; }
    u32x4 w0, w1;
    w0.x = cvt_pk_bf16(kv[0], kv[1]); w0.y = cvt_pk_bf16(kv[2], kv[3]); w0.z = cvt_pk_bf16(kv[4], kv[5]); w0.w = cvt_pk_bf16(kv[6], kv[7]);
    w1.x = cvt_pk_bf16(kv[8], kv[9]); w1.y = cvt_pk_bf16(kv[10], kv[11]); w1.z = cvt_pk_bf16(kv[12], kv[13]); w1.w = cvt_pk_bf16(kv[14], kv[15]);
    *(LAS u32x4*)(kd + k * 72 + tq * 16) = w0; *(LAS u32x4*)(kd + k * 72 + tq * 16 + 8) = w1;
    if (tq == 0) { const float d = __expf(r); decs[k] = d; dprod = first ? d : dprod * d; if (last && decg) decg[k] = dprod; }
}
__device__ __forceinline__ void p2b_mfma(const LAS unsigned short* kd, const LAS unsigned short* vT, const LAS float* decs, int un, int su, bool first, bool last,
                                         f32x16& acc0, f32x16& acc1, bf16_t* DST, const float* st_hgrn, float* out_hs, int wave, int lane) {
    const int cidx = un >> 3, h = un & 7;
    const int kt = wave >> 1, vt0 = (wave & 1) * 2, r = lane & 31, hh = lane >> 5;
    const int v0 = vt0 * 32 + r, v1 = v0 + 32;
    if (first) {
#pragma unroll
        for (int i = 0; i < 16; ++i) { acc0[i] = 0.f; acc1[i] = 0.f; }
    } else {
#pragma unroll
        for (int i = 0; i < 16; ++i) { const float d = decs[kt * 32 + (i & 3) + 8 * (i >> 2) + 4 * hh]; acc0[i] *= d; acc1[i] *= d; }
    }
#pragma unroll
    for (int ks = 0; ks < 4; ++ks) {
        const bf16x8 af = *(const LAS bf16x8*)(kd + (kt * 32 + r) * 72 + 16 * ks + 8 * hh);
        const bf16x8 b0 = *(const LAS bf16x8*)(vT + v0 * 72 + VT_GRP(v0, 2 * ks + hh));
        const bf16x8 b1 = *(const LAS bf16x8*)(vT + v1 * 72 + VT_GRP(v1, 2 * ks + hh));
        acc0 = __builtin_amdgcn_mfma_f32_32x32x16_bf16(af, b0, acc0, 0, 0, 0);
        acc1 = __builtin_amdgcn_mfma_f32_32x32x16_bf16(af, b1, acc1, 0, 0, 0);
    }
    if (!last) return;
    if (su >= 0) {
        bf16_t* dp = DST + (size_t)su * 16384 + (kt * 4 + vt0) * 1024 + lane * 4;
#pragma unroll
        for (int q = 0; q < 4; ++q) {
            u32x2 w0, w1; w0.x = cvt_pk_bf16(acc0[4 * q], acc0[4 * q + 1]); w0.y = cvt_pk_bf16(acc0[4 * q + 2], acc0[4 * q + 3]);
            w1.x = cvt_pk_bf16(acc1[4 * q], acc1[4 * q + 1]); w1.y = cvt_pk_bf16(acc1[4 * q + 2], acc1[4 * q + 3]);
            *(u32x2*)(dp + q * 256) = w0; *(u32x2*)(dp + 1024 + q * 256) = w1; }
    } else {
        const size_t sbase = ((size_t)(cidx - NCHUNK_P) * 8 + h) * 16384;
        const float* s0 = st_hgrn + sbase; float* so = out_hs + sbase;
        float p0[16], p1[16];
#pragma unroll
        for (int i = 0; i < 16; ++i) { const int k = kt * 32 + (i & 3) + 8 * (i >> 2) + 4 * hh; p0[i] = s0[k * 128 + v0]; p1[i] = s0[k * 128 + v1]; }
#pragma unroll
        for (int i = 0; i < 16; ++i) { const int k = kt * 32 + (i & 3) + 8 * (i >> 2) + 4 * hh; const float d = decs[k];
            so[k * 128 + v0] = d * p0[i] + acc0[i]; so[k * 128 + v1] = d * p1[i] + acc1[i]; }
    }
}

__device__ __forceinline__ f32x16 mini_gemm(LAS unsigned char* lds, const bf16_t* A, int lda, const bf16_t* Bt, int ldb, int K, int tid, int wave, int lane, f32x16 acc) {
    LAS unsigned short* As0 = (LAS unsigned short*)lds;
    LAS unsigned short* Bs0 = (LAS unsigned short*)(lds + 2 * 9216);
    const int lr = tid >> 3, lp = (tid & 7) * 8;
    const bf16_t* ap = A + (size_t)lr * lda + lp;
    const bf16_t* bp0 = Bt + (size_t)lr * ldb + lp; const bf16_t* bp1 = Bt + (size_t)(lr + 64) * ldb + lp;
    const int nk = K / 64;
    u32x4 ra[4], rb0[4], rb1[4];
#pragma unroll
    for (int s = 0; s < 4; ++s) { ra[s] = *(const u32x4*)(ap + 64 * s); rb0[s] = *(const u32x4*)(bp0 + 64 * s); rb1[s] = *(const u32x4*)(bp1 + 64 * s); }
    *(LAS u32x4*)(As0 + lr * 72 + lp) = ra[0]; *(LAS u32x4*)(Bs0 + lr * 72 + lp) = rb0[0]; *(LAS u32x4*)(Bs0 + (lr + 64) * 72 + lp) = rb1[0];
    __syncthreads();
    const int wr2 = wave >> 2, wc4 = wave & 3, r = lane & 31, hh = lane >> 5;
    for (int kt0 = 0; kt0 < nk; kt0 += 4) {
#pragma unroll
        for (int u = 0; u < 4; ++u) {
            const int kt = kt0 + u;
            if (kt + 4 < nk) { const int ko = (kt + 4) * 64; ra[u] = *(const u32x4*)(ap + ko); rb0[u] = *(const u32x4*)(bp0 + ko); rb1[u] = *(const u32x4*)(bp1 + ko); }
            const LAS unsigned short* As = As0 + (u & 1) * (64 * 72); const LAS unsigned short* Bs = Bs0 + (u & 1) * (128 * 72);
#pragma unroll
            for (int ks = 0; ks < 4; ++ks) {
                const bf16x8 af = *(const LAS bf16x8*)(As + (wr2 * 32 + r) * 72 + 16 * ks + 8 * hh);
                const bf16x8 bfr = *(const LAS bf16x8*)(Bs + (wc4 * 32 + r) * 72 + 16 * ks + 8 * hh);
                acc = __builtin_amdgcn_mfma_f32_32x32x16_bf16(af, bfr, acc, 0, 0, 0);
            }
            if (kt + 1 < nk) {
                LAS unsigned short* An = As0 + ((u + 1) & 1) * (64 * 72); LAS unsigned short* Bn = Bs0 + ((u + 1) & 1) * (128 * 72);
                *(LAS u32x4*)(An + lr * 72 + lp) = ra[(u + 1) & 3]; *(LAS u32x4*)(Bn + lr * 72 + lp) = rb0[(u + 1) & 3]; *(LAS u32x4*)(Bn + (lr + 64) * 72 + lp) = rb1[(u + 1) & 3];
            }
            __syncthreads();
        }
    }
    return acc;
}

#define XB_TMO      128
#define XB_XCNT(j)  (256  + 64 * (j))
#define XB_XSUB(j)  (1280 + 64 * (j))
#define XB_XGEN(j)  (2304 + 64 * (j))
#define XB_TOP      3328
#define XB_TOPGEN   3392
#define XCD_BAR_WORDS 3456
#define XB_SPIN_CAP (1u << 18)
__device__ __forceinline__ unsigned xb_ld(unsigned* p)              { return __hip_atomic_load(p, __ATOMIC_RELAXED, __HIP_MEMORY_SCOPE_AGENT); }
__device__ __forceinline__ unsigned xb_add(unsigned* p, unsigned v) { return __hip_atomic_fetch_add(p, v, __ATOMIC_RELAXED, __HIP_MEMORY_SCOPE_AGENT); }
__device__ __forceinline__ unsigned xb_xcc_id() { return (unsigned)__builtin_amdgcn_s_getreg((3 << 11) | 20) & 0xFu; }
#define XB_SPIN(cond, bar) do { unsigned _sp = 0; while (cond) { __builtin_amdgcn_s_sleep(1); \
    if ((++_sp & 255u) == 0u) { if (xb_ld(&(bar)[XB_TMO])) break; if (_sp > XB_SPIN_CAP) { atomicAdd(&(bar)[XB_TMO], 1u); break; } } } } while (0)
struct XcdBarrier { unsigned* bar; unsigned x; volatile LAS unsigned* st; };
__device__ __forceinline__ XcdBarrier xcd_barrier_post(unsigned* bar, volatile LAS unsigned* st) {
    XcdBarrier b; b.bar = bar; b.x = xb_xcc_id(); b.st = st;
    if (threadIdx.x == 0) (void)xb_add(&bar[XB_XCNT(b.x)], 1u);
    return b;
}
__device__ __forceinline__ void xcd_barrier_complete(unsigned* bar, unsigned x, unsigned& nloc, unsigned& nx) {
    const unsigned G = gridDim.x * gridDim.y * gridDim.z;
    unsigned sum, cnt, mine, sp = 0u;
    for (;;) {
        sum = 0u; cnt = 0u; mine = 0u;
#pragma unroll
        for (unsigned j = 0; j < 16; ++j) { const unsigned c = xb_ld(&bar[XB_XCNT(j)]); sum += c; cnt += (c > 0u) ? 1u : 0u; mine = (j == x) ? c : mine; }
        if (sum == G) break;
        __builtin_amdgcn_s_sleep(1);
        if ((++sp & 255u) == 0u) { if (xb_ld(&bar[XB_TMO])) break; if (sp > XB_SPIN_CAP) { atomicAdd(&bar[XB_TMO], 1u); break; } }
    }
    nloc = mine > 0u ? mine : 1u; nx = cnt > 0u ? cnt : 1u;
}
__device__ __forceinline__ void xcd_barrier(const XcdBarrier& b) {
    asm volatile("s_waitcnt vmcnt(0)" ::: "memory");
    __syncthreads();
    if (threadIdx.x == 0) {
        unsigned* bar = b.bar;
        __builtin_amdgcn_s_waitcnt(0);
        unsigned nloc = b.st[0], nx = b.st[1];
        if (nloc == 0u) { xcd_barrier_complete(bar, b.x, nloc, nx); b.st[0] = nloc; b.st[1] = nx; }
        const unsigned old = xb_add(&bar[XB_XSUB(b.x)], 1u);
        const unsigned gen = old / nloc;
        if (old + 1u == (gen + 1u) * nloc) {
            __builtin_amdgcn_fence(__ATOMIC_RELEASE, "agent");
            asm volatile("s_waitcnt vmcnt(0)" ::: "memory");
            const unsigned og = xb_add(&bar[XB_TOP], 1u);
            const unsigned tg = og / nx;
            if (og + 1u == (tg + 1u) * nx) xb_add(&bar[XB_TOPGEN], 1u);
            else XB_SPIN(xb_ld(&bar[XB_TOPGEN]) == tg, bar);
            __builtin_amdgcn_fence(__ATOMIC_ACQUIRE, "agent");
            xb_add(&bar[XB_XGEN(b.x)], 1u);
            asm volatile("s_waitcnt vmcnt(0)" ::: "memory");
        } else {
            XB_SPIN(xb_ld(&bar[XB_XGEN(b.x)]) == gen, bar);
            __builtin_amdgcn_fence(__ATOMIC_ACQUIRE, "agent");
            asm volatile("s_waitcnt vmcnt(0)" ::: "memory");
        }
    }
    __syncthreads();
}
#define GSYNC() xcd_barrier(bar)

constexpr int LDS_BYTES = 148480;

__global__ void __launch_bounds__(512, 2) fwd_kernel(Args a) {
    extern __shared__ __attribute__((aligned(16))) unsigned char lds_raw[];
    LAS unsigned char* lds = (LAS unsigned char*)lds_raw;
    const int tid = threadIdx.x, lane = tid & 63, wave = __builtin_amdgcn_readfirstlane(tid >> 6);
    const int G = gridDim.x, bid = blockIdx.x;
    const int gw = bid * 8 + wave, NGW = G * 8;
    const int gt = bid * 512 + tid, NGT = G * 512;
    volatile LAS unsigned* stw = (volatile LAS unsigned*)(lds + LDS_BYTES - 16);
    if (tid < 4) stw[tid] = 0u;
    __syncthreads();
    const XcdBarrier bar = xcd_barrier_post((unsigned*)(a.ws + WS_BAR), stw);

    const float* x_p = a.in[0]; const float* x_s = a.in[1]; const float* st_conv = a.in[2]; const float* st_hgrn = a.in[3];
    const float* p_p = a.in[4]; const float* p_s = a.in[5]; const float* w_in = a.in[6]; const float* conv_w = a.in[7]; const float* lb_raw = a.in[8];
    const float* g_pre = a.in[9]; const float* g_onorm = a.in[10]; const float* w_a_out = a.in[11]; const float* w_b_out = a.in[12]; const float* w_o = a.in[13];
    const float* g_post = a.in[14]; const float* g_ple = a.in[15]; const float* w_ple_gate = a.in[16]; const float* w_ple_proj = a.in[17];
    unsigned char* ws = a.ws; float* out = a.out;
    bf16_t* GA = (bf16_t*)(ws + WS_GA); bf16_t* Q = (bf16_t*)(ws + WS_Q); unsigned short* LFH = (unsigned short*)(ws + WS_LFH); bf16_t* V = (bf16_t*)(ws + WS_V);
    bf16_t* SZ = (bf16_t*)(ws + WS_SZ); bf16_t* UF = (bf16_t*)(ws + WS_U + 40 * MiB);    bf16_t* XB = (bf16_t*)(ws + WS_XB);
    bf16_t* BTIN = (bf16_t*)(ws + WS_BTIN); bf16_t* BTAB = (bf16_t*)(ws + WS_BTAB); bf16_t* BTO = (bf16_t*)(ws + WS_BTO); bf16_t* BTG = (bf16_t*)(ws + WS_BTG); bf16_t* BTP = (bf16_t*)(ws + WS_BTP);
    float* RINV = (float*)(ws + WS_RINV); float* R1 = (float*)(ws + WS_R1); float* LBV = (float*)(ws + WS_LBV); float* DEC = (float*)(ws + WS_DEC); float* SSQ = (float*)(ws + WS_SSQ); float* SSQ2 = (float*)(ws + WS_SSQ2);
    bf16_t* DST = (bf16_t*)(ws + WS_DST); bf16_t* MG = (bf16_t*)(ws + WS_MG); bf16_t* OUTB = (bf16_t*)(ws + WS_OUT); bf16_t* X1B = (bf16_t*)(ws + WS_X1B);
    bf16_t* PB = (bf16_t*)(ws + WS_PB); bf16_t* PP = (bf16_t*)(ws + WS_PP);
    bf16_t* SGA = (bf16_t*)(out + O_Y); bf16_t* SGB = (bf16_t*)((unsigned char*)(out + O_Y) + BUF);

    {
        LAS float* scr = (LAS float*)(lds + wave * 16384);
        constexpr int I_IN = 16 * 320, I_SQ = 16 * 32, I_P = 4 * 32;
        constexpr int NITEMS = I_IN + 4 * I_SQ + I_P;
        for (int it = gw; it < NITEMS; it += NGW) {
            int r = it;
            if (r < I_IN) {
                const int kb = r / 320, nb = r % 320, n0 = nb * 32, seg = n0 >> 10, ch = n0 & 1023;
                if (seg < 4) {
                    const int kind = ((seg & 1) << 1) | (seg >> 1);
                    const int drowa = (ch >> 6) * 256 + 128 * (kind >> 1) + 32 * ((ch >> 4) & 3) + 4 * (kind & 1);
                    p0_transpose(w_in, NIN, g_pre, BTIN, DM, 0, drowa, kb * 64, n0, scr, lane, true); continue; }
                const int code = seg;
                const int drow = (((code >> 1) * 8 + (ch >> 7)) * 256) + (code & 1) * 128 + (ch & 127);
                p0_transpose(w_in, NIN, g_pre, BTIN, DM, 0, drow, kb * 64, n0, scr, lane); continue; }
            r -= I_IN;
            if (r < I_SQ) { p0_transpose(w_a_out, DM, nullptr, BTAB, 2048, 0, (r % 32) * 32, (r / 32) * 64, (r % 32) * 32, scr, lane); continue; } r -= I_SQ;
            if (r < I_SQ) { p0_transpose(w_b_out, DM, g_onorm, BTAB, 2048, 1024, (r % 32) * 32, (r / 32) * 64, (r % 32) * 32, scr, lane); continue; } r -= I_SQ;
            if (r < I_SQ) { p0_transpose(w_o, DM, nullptr, BTO, DM, 0, (r % 32) * 32, (r / 32) * 64, (r % 32) * 32, scr, lane); continue; } r -= I_SQ;
            if (r < I_SQ) { p0_transpose(w_ple_gate, DM, g_ple, BTG, DM, 0, (r % 32) * 32, (r / 32) * 64, (r % 32) * 32, scr, lane); continue; } r -= I_SQ;
            p0_transpose(w_ple_proj, DM, nullptr, BTP, DPLE, 0, (r % 32) * 32, (r / 32) * 64, (r % 32) * 32, scr, lane);
        }
        for (int m0 = gw; m0 < M_TOK; m0 += 2 * NGW) {
            const int m1 = m0 + NGW; const bool has1 = m1 < M_TOK; const int m1c = has1 ? m1 : m0;
            const f32x4* xr0 = (const f32x4*)((m0 < MP) ? x_p + (size_t)m0 * DM : x_s + (size_t)(m0 - MP) * DM) + lane;
            const f32x4* xr1 = (const f32x4*)((m1c < MP) ? x_p + (size_t)m1c * DM : x_s + (size_t)(m1c - MP) * DM) + lane;
            f32x4 v0[4], v1[4]; float s0 = 0.f, s1 = 0.f;
#pragma unroll
            for (int j = 0; j < 4; ++j) { v0[j] = __builtin_nontemporal_load(xr0 + 64 * j); v1[j] = __builtin_nontemporal_load(xr1 + 64 * j); }
#pragma unroll
            for (int j = 0; j < 4; ++j) { s0 += (v0[j][0] * v0[j][0] + v0[j][1] * v0[j][1]) + (v0[j][2] * v0[j][2] + v0[j][3] * v0[j][3]);
                                          s1 += (v1[j][0] * v1[j][0] + v1[j][1] * v1[j][1]) + (v1[j][2] * v1[j][2] + v1[j][3] * v1[j][3]); }
            s0 = wave_sum(s0); s1 = wave_sum(s1);
            if (lane == 0) { RINV[m0] = rsqrtf(s0 * (1.0f / DM) + EPS); if (has1) RINV[m1] = rsqrtf(s1 * (1.0f / DM) + EPS); }
            u32x2* o0 = (u32x2*)(XB + (size_t)m0 * DM) + lane; u32x2* o1 = (u32x2*)(XB + (size_t)m1c * DM) + lane;
#pragma unroll
            for (int j = 0; j < 4; ++j) { u32x2 w; w.x = cvt_pk_bf16(v0[j][0], v0[j][1]); w.y = cvt_pk_bf16(v0[j][2], v0[j][3]); o0[64 * j] = w; }
            if (has1) {
#pragma unroll
                for (int j = 0; j < 4; ++j) { u32x2 w; w.x = cvt_pk_bf16(v1[j][0], v1[j][1]); w.y = cvt_pk_bf16(v1[j][2], v1[j][3]); o1[64 * j] = w; }
            }
        }
        if (bid == 0) for (int j = tid; j < 1024; j += 512) { const float e0 = __expf(lb_raw[j]), e1 = __expf(lb_raw[1024 + j]); LBV[j] = e0 / (e0 + e1); }
    }
    GSYNC();

    {
        pg8::Gemm g{XB, nullptr, BTIN, M_TOK, NIN, DM, DM, DM, 0}; pg8::StaticOrder S; S.init(M_TOK, NIN, G, bid);
        Epi1 E{RINV, LBV, UF, GA, Q, V, SZ, SGA, SGB, LFH, out + O_CONVP, out + O_CONVS, conv_w, lds + 131072};
        pg8::gemm_phase<Epi1, true, true>(lds, g, S, E);
    }
    GSYNC();

    {
        for (int it = gt; it < (M_TOK / 64) * 2 * 128; it += NGT) {
            const int c8 = (it & 127) * 8, t = (it >> 7) & 1, blk = it >> 8; const int row = blk * 64 + t;
            const bool seq0 = (blk >= NCHUNK_P) || ((blk & 127) == 0);
            f32x4 u2a, u2b, u1a, u1b, u0a, u0b;
            unpack8(*(const u32x4*)(UF + ((size_t)blk * 4 + t) * DM + c8), u2a, u2b);
            if (t == 1) unpack8(*(const u32x4*)(UF + ((size_t)blk * 4 + 0) * DM + c8), u1a, u1b);
            else if (!seq0) unpack8(*(const u32x4*)(UF + ((size_t)(blk - 1) * 4 + 3) * DM + c8), u1a, u1b);
            else if (blk >= NCHUNK_P) { const float* hp = st_conv + ((size_t)(blk - NCHUNK_P) * 2 + 1) * DM + c8; u1a = *(const f32x4*)hp; u1b = *(const f32x4*)(hp + 4); }
            else { u1a = (f32x4){0.f, 0.f, 0.f, 0.f}; u1b = u1a; }
            if (!seq0) unpack8(*(const u32x4*)(UF + ((size_t)(blk - 1) * 4 + 2 + t) * DM + c8), u0a, u0b);
            else if (blk >= NCHUNK_P) { const float* hp = st_conv + ((size_t)(blk - NCHUNK_P) * 2 + t) * DM + c8; u0a = *(const f32x4*)hp; u0b = *(const f32x4*)(hp + 4); }
            else { u0a = (f32x4){0.f, 0.f, 0.f, 0.f}; u0b = u0a; }
            const f32x4 w0a = *(const f32x4*)(conv_w + c8), w0b = *(const f32x4*)(conv_w + c8 + 4);
            const f32x4 w1a = *(const f32x4*)(conv_w + DM + c8), w1b = *(const f32x4*)(conv_w + DM + c8 + 4);
            const f32x4 w2a = *(const f32x4*)(conv_w + 2 * DM + c8), w2b = *(const f32x4*)(conv_w + 2 * DM + c8 + 4);
            f32x4 ga, gb; u32x4* gp = (u32x4*)(GA + (size_t)row * DM + c8); unpack8(*gp, ga, gb);
            *gp = pack8(ga * (w0a * u0a + w1a * u1a + w2a * u2a), gb * (w0b * u0b + w1b * u1b + w2b * u2b));
        }
        for (int it = gt; it < M_TOK * 32; it += NGT) {
            const int row = it >> 5, c8 = (it & 31) * 8;
            const float* pr = (row < MP) ? p_p + (size_t)row * DPLE + c8 : p_s + (size_t)(row - MP) * DPLE + c8;
            *(u32x4*)(PB + (size_t)row * DPLE + c8) = pack8(*(const f32x4*)pr, *(const f32x4*)(pr + 4));
        }
    }

#define LOAD_TILE2(dst, X, un_) do { const int c_ = (un_) >> 3, h_ = (un_) & 7; _Pragma("unroll") for (int i_ = 0; i_ < 2; ++i_) { const int p_ = tid + 512 * i_; \
        dst[i_] = *(const u32x4*)((X) + ((size_t)c_ * 64 + (p_ >> 4)) * DM + h_ * 128 + (p_ & 15) * 8); } } while (0)
#define LOAD_TILE2_NT(dst, X, un_) do { const int c_ = (un_) >> 3, h_ = (un_) & 7; _Pragma("unroll") for (int i_ = 0; i_ < 2; ++i_) { const int p_ = tid + 512 * i_; \
        dst[i_] = __builtin_nontemporal_load((const u32x4*)((X) + ((size_t)c_ * 64 + (p_ >> 4)) * DM + h_ * 128 + (p_ & 15) * 8)); } } while (0)
#define SCATTER_VT(vt_, w_, s_, vg_) do { LAS unsigned short* d_ = (vt_) + ((vg_) * 8) * 72 + VT_GRP((vg_) * 8, (s_) >> 3) + ((s_) & 7); \
        d_[0 * 72] = (unsigned short)((w_).x & 0xffff); d_[1 * 72] = (unsigned short)((w_).x >> 16); d_[2 * 72] = (unsigned short)((w_).y & 0xffff); d_[3 * 72] = (unsigned short)((w_).y >> 16); \
        d_[4 * 72] = (unsigned short)((w_).z & 0xffff); d_[5 * 72] = (unsigned short)((w_).z >> 16); d_[6 * 72] = (unsigned short)((w_).w & 0xffff); d_[7 * 72] = (unsigned short)((w_).w >> 16); } while (0)
    {
        LAS unsigned short* LFb = (LAS unsigned short*)lds;
        LAS unsigned short* kdb = (LAS unsigned short*)(lds + 34816);
        LAS unsigned short* vTb = (LAS unsigned short*)(lds + 71680);
        LAS float* decb = (LAS float*)(lds + 126976);
        const int nsu = (bid < NSU) ? (NSU - bid + G - 1) / G : 0, nps = NSC * nsu;
        const int nst = nps + ((bid < NSMP) ? (NSMP - bid + G - 1) / G : 0);
        u32x4 plf[2], pv[2];
        f32x16 acc0, acc1; float dprod = 1.f;
#pragma unroll
        for (int i = 0; i < 16; ++i) { acc0[i] = 0.f; acc1[i] = 0.f; }
#define P2B_LOAD(j_) do { int un_, su_; bool f_, l_; step_map((j_), nps, bid, G, un_, su_, f_, l_); LOAD_TILE2(plf, LFH, un_); LOAD_TILE2(pv, V, un_); } while (0)
#define P2B_STAGE(j_) do { LAS unsigned short* LF_ = LFb + ((j_) & 1) * (64 * 136); LAS unsigned short* vT_ = vTb + ((j_) % 3) * (128 * 72); \
        _Pragma("unroll") for (int i = 0; i < 2; ++i) { const int p = tid + 512 * i, t = p >> 4, g8 = p & 15; *(LAS u32x4*)(LF_ + t * 136 + g8 * 8) = plf[i]; SCATTER_VT(vT_, pv[i], t, g8); } } while (0)
#define P2B_SCAN(j_) do { int un_, su_; bool f_, l_; step_map((j_), nps, bid, G, un_, su_, f_, l_); \
        p2b_scan(LFb + ((j_) & 1) * (64 * 136), kdb + ((j_) & 1) * (128 * 72), decb + ((j_) & 1) * 128, su_ >= 0 ? DEC + (size_t)su_ * 128 : nullptr, f_, l_, dprod, tid); } while (0)
        if (nst > 0) {
            P2B_LOAD(0); P2B_STAGE(0);
            if (nst > 1) P2B_LOAD(1);
            __syncthreads();
            P2B_SCAN(0);
            if (nst > 1) P2B_STAGE(1);
            if (nst > 2) P2B_LOAD(2);
            __syncthreads();
            for (int j = 0; j < nst; ++j) {
                if (j + 2 < nst) P2B_STAGE(j + 2);
                if (j + 3 < nst) P2B_LOAD(j + 3);
                { int un, su; bool first, last; step_map(j, nps, bid, G, un, su, first, last);
                  p2b_mfma(kdb + (j & 1) * (128 * 72), vTb + (j % 3) * (128 * 72), decb + (j & 1) * 128, un, su, first, last, acc0, acc1, DST, st_hgrn, out + O_HS, wave, lane); }
                if (j + 1 < nst) P2B_SCAN(j + 1);
                __syncthreads();
            }
        }
    }
    GSYNC();

    {
        constexpr int NSQ = NCHUNK_P / NSC / 4;
        for (int it = gt; it < 32 * 4096; it += NGT) {
            const int bh = it >> 12, g4 = it & 4095, b = bh >> 3, h = bh & 7;
            const int v = ((g4 >> 8) & 3) * 32 + (g4 & 31), k0 = (g4 >> 10) * 32 + 8 * ((g4 >> 6) & 3) + 4 * ((g4 >> 5) & 1);
            float S0 = 0.f, S1 = 0.f, S2 = 0.f, S3 = 0.f;
            for (int c0 = 0; c0 < NSQ; c0 += 8) {
                u32x2 ds[8]; f32x4 dc[8];
#pragma unroll
                for (int j = 0; j < 8; ++j) { const size_t su = ((size_t)(b * NSQ + c0 + j)) * 8 + h; ds[j] = *(const u32x2*)(DST + su * 16384 + g4 * 4); dc[j] = *(const f32x4*)(DEC + su * 128 + k0); }
#pragma unroll
                for (int j = 0; j < 8; ++j) { const size_t su = ((size_t)(b * NSQ + c0 + j)) * 8 + h;
                    u32x2 w; w.x = cvt_pk_bf16(S0, S1); w.y = cvt_pk_bf16(S2, S3);
                    *(u32x2*)(DST + su * 16384 + g4 * 4) = w;
                    S0 = dc[j][0] * S0 + bflo(ds[j].x); S1 = dc[j][1] * S1 + bfhi(ds[j].x); S2 = dc[j][2] * S2 + bflo(ds[j].y); S3 = dc[j][3] * S3 + bfhi(ds[j].y); }
            }
            float* so = out + O_HP + (size_t)bh * 16384;
            so[(k0 + 0) * 128 + v] = S0; so[(k0 + 1) * 128 + v] = S1; so[(k0 + 2) * 128 + v] = S2; so[(k0 + 3) * 128 + v] = S3;
        }
    }
    GSYNC();

    {
        LAS unsigned short* LF = (LAS unsigned short*)lds;
        LAS unsigned short* QS = (LAS unsigned short*)(lds + 17408);
        LAS unsigned short* vT = (LAS unsigned short*)(lds + 34816);
        LAS unsigned short* qe = (LAS unsigned short*)(lds + 53248);
        LAS unsigned short* ke = (LAS unsigned short*)(lds + 70656);
        LAS unsigned short* qb = (LAS unsigned short*)(lds + 88064);
        LAS unsigned short* kd = (LAS unsigned short*)(lds + 105472);
        LAS unsigned short* ost = (LAS unsigned short*)(lds + 123904);
        LAS float* qsum = (LAS float*)(lds + 141312);
        LAS float* decs = (LAS float*)(lds + 143360);
        const int nsu = (bid < NSU) ? (NSU - bid + G - 1) / G : 0, nps = NSC * nsu;
        const int nst = nps + ((bid < NSMP) ? (NSMP - bid + G - 1) / G : 0);
        const int tb = wave & 1, vb = wave >> 1, r = lane & 31, hh = lane >> 5;
        u32x4 plf[2], pq[2], pv[2];
        u32x4 sfr[8];
#pragma unroll
        for (int i = 0; i < 8; ++i) sfr[i] = (u32x4){0u, 0u, 0u, 0u};
        if (nst > 0) { int un_, su_; bool f_, l_; step_map(0, nps, bid, G, un_, su_, f_, l_); LOAD_TILE2_NT(plf, LFH, un_); LOAD_TILE2_NT(pq, Q, un_); LOAD_TILE2_NT(pv, V, un_); }
        for (int j = 0; j < nst; ++j) {
            int un, su; bool first, last; step_map(j, nps, bid, G, un, su, first, last);
            const int cidx = un >> 3, h = un & 7; const size_t row0 = (size_t)cidx * 64;
#pragma unroll
            for (int i = 0; i < 2; ++i) { const int p = tid + 512 * i, t = p >> 4, g8 = p & 15;
                *(LAS u32x4*)(LF + t * 136 + g8 * 8) = plf[i]; *(LAS u32x4*)(QS + t * 136 + g8 * 8) = pq[i]; SCATTER_VT(vT, pv[i], t, g8); }
            if (first) {
                if (su >= 0) {
                    const bf16_t* sp = DST + (size_t)su * 16384 + vb * 1024 + launder(lane) * 4;
#pragma unroll
                    for (int kt = 0; kt < 4; ++kt)
#pragma unroll
                        for (int s2 = 0; s2 < 2; ++s2) { const u32x2 lo = *(const u32x2*)(sp + kt * 4096 + (2 * s2) * 256), hi = *(const u32x2*)(sp + kt * 4096 + (2 * s2 + 1) * 256);
                            sfr[kt * 2 + s2] = (u32x4){lo.x, lo.y, hi.x, hi.y}; }
                } else {
                    const float* s0 = st_hgrn + ((size_t)(cidx - NCHUNK_P) * 8 + h) * 16384 + vb * 32 + r;
#pragma unroll
                    for (int f8 = 0; f8 < 8; ++f8) { float sv[8];
#pragma unroll
                        for (int e = 0; e < 8; ++e) sv[e] = s0[(size_t)(16 * f8 + 8 * (e >> 2) + 4 * hh + (e & 3)) * 128];
                        sfr[f8] = (u32x4){cvt_pk_bf16(sv[0], sv[1]), cvt_pk_bf16(sv[2], sv[3]), cvt_pk_bf16(sv[4], sv[5]), cvt_pk_bf16(sv[6], sv[7])}; }
                }
            }
            __syncthreads();
            if (j + 1 < nst) { int un_, su_; bool f_, l_; step_map(j + 1, nps, bid, G, un_, su_, f_, l_); LOAD_TILE2_NT(plf, LFH, un_); LOAD_TILE2_NT(pq, Q, un_); LOAD_TILE2_NT(pv, V, un_); }
            {
                const int k = tid & 127, tq = tid >> 7;
                float lfv[16]; float ssum = 0.f;
#pragma unroll
                for (int jj = 0; jj < 16; ++jj) { lfv[jj] = h2f(LF[(tq * 16 + jj) * 136 + k]); ssum += lfv[jj]; }
                qsum[tq * 128 + k] = ssum;
                __syncthreads();
                const float s0q = qsum[k], s1q = qsum[128 + k], s2q = qsum[256 + k], s3q = qsum[384 + k];
                const float ref = s0q + s1q, btot = (s0q + s1q) + (s2q + s3q);
                float b = (tq > 0 ? s0q : 0.f) + (tq > 1 ? s1q : 0.f) + (tq > 2 ? s2q : 0.f);
                float kv[16];
                const float eref = __expf(ref), etot = __expf(btot - ref); float e1 = __expf(b - ref);
#pragma unroll
                for (int jj = 0; jj < 16; ++jj) { const int t = tq * 16 + jj;
                    const float q = silu_f(bf2f(QS[t * 136 + k])) * QK_SCALE;
                    b += lfv[jj];
                    const float fj = __expf(lfv[jj]); const float kk = 1.0f - fj;
                    e1 *= fj;
                    const float qev = q * e1, kev = kk * __builtin_amdgcn_rcpf(e1);
                    kv[jj] = kev * etot;
                    qe[t * 136 + k] = f2bf(qev); ke[t * 136 + k] = f2bf(kev); qb[t * 136 + k] = f2bf(qev * eref); }
                u32x4 w0, w1;
                w0.x = cvt_pk_bf16(kv[0], kv[1]); w0.y = cvt_pk_bf16(kv[2], kv[3]); w0.z = cvt_pk_bf16(kv[4], kv[5]); w0.w = cvt_pk_bf16(kv[6], kv[7]);
                w1.x = cvt_pk_bf16(kv[8], kv[9]); w1.y = cvt_pk_bf16(kv[10], kv[11]); w1.z = cvt_pk_bf16(kv[12], kv[13]); w1.w = cvt_pk_bf16(kv[14], kv[15]);
                *(LAS u32x4*)(kd + k * 72 + tq * 16) = w0; *(LAS u32x4*)(kd + k * 72 + tq * 16 + 8) = w1;
                if (tq == 0) decs[k] = __expf(btot);
            }
            __syncthreads();
            f32x16 oacc;
#pragma unroll
            for (int i = 0; i < 16; ++i) oacc[i] = 0.f;
            {
                const LAS unsigned short* qrow = qb + (tb * 32 + r) * 136 + 4 * hh;
#pragma unroll
                for (int kt = 0; kt < 4; ++kt)
#pragma unroll
                    for (int s2 = 0; s2 < 2; ++s2) {
                        const bf16x8 bfr = __builtin_bit_cast(bf16x8, sfr[kt * 2 + s2]);
                        const s16x4 lo = *(const LAS s16x4*)(qrow + 32 * kt + 16 * s2), hi = *(const LAS s16x4*)(qrow + 32 * kt + 16 * s2 + 8);
                        const bf16x8 af = __builtin_shufflevector(lo, hi, 0, 1, 2, 3, 4, 5, 6, 7);
                        oacc = __builtin_amdgcn_mfma_f32_32x32x16_bf16(af, bfr, oacc, 0, 0, 0);
                        if (s2 == 1) __builtin_amdgcn_sched_barrier(0);
                    }
            }
            __builtin_amdgcn_sched_barrier(0);
            const int vrow = vb * 32 + r;
            for (int sb = 0; sb <= tb; ++sb) {
                f32x16 att;
#pragma unroll
                for (int i = 0; i < 16; ++i) att[i] = 0.f;
#pragma unroll
                for (int ks = 0; ks < 8; ++ks) {
                    const bf16x8 af = *(const LAS bf16x8*)(ke + (sb * 32 + r) * 136 + 16 * ks + 8 * hh);
                    const bf16x8 bfr = *(const LAS bf16x8*)(qe + (tb * 32 + r) * 136 + 16 * ks + 8 * hh);
                    att = __builtin_amdgcn_mfma_f32_32x32x16_bf16(af, bfr, att, 0, 0, 0);
                    if (ks & 1) __builtin_amdgcn_sched_barrier(0);
                }
                if (sb == tb) {
#pragma unroll
                    for (int i = 0; i < 16; ++i) { const int sl = (i & 3) + 8 * (i >> 2) + 4 * hh; if (sl > r) att[i] = 0.f; }
                }
#pragma unroll
                for (int s2 = 0; s2 < 2; ++s2) {
                    u32x4 w; w.x = cvt_pk_bf16(att[8 * s2 + 0], att[8 * s2 + 1]); w.y = cvt_pk_bf16(att[8 * s2 + 2], att[8 * s2 + 3]);
                    w.z = cvt_pk_bf16(att[8 * s2 + 4], att[8 * s2 + 5]); w.w = cvt_pk_bf16(att[8 * s2 + 6], att[8 * s2 + 7]);
                    const bf16x8 af = __builtin_bit_cast(bf16x8, w);
                    const LAS unsigned short* vp = vT + vrow * 72 + 4 * hh;
                    const s16x4 lo = *(const LAS s16x4*)(vp + VT_GRP(vrow, sb * 4 + 2 * s2)), hi = *(const LAS s16x4*)(vp + VT_GRP(vrow, sb * 4 + 2 * s2 + 1));
                    const bf16x8 bfr = __builtin_shufflevector(lo, hi, 0, 1, 2, 3, 4, 5, 6, 7);
                    oacc = __builtin_amdgcn_mfma_f32_32x32x16_bf16(af, bfr, oacc, 0, 0, 0);
                }
            }
#pragma unroll
            for (int i = 0; i < 16; ++i) ost[(tb * 32 + (i & 3) + 8 * (i >> 2) + 4 * hh) * 136 + vb * 32 + r] = f2bf(oacc[i]);
            __builtin_amdgcn_sched_barrier(0);
            if (!last) {
#pragma unroll
                for (int kt = 0; kt < 4; ++kt) {
                    f32x16 d;
#pragma unroll
                    for (int s2 = 0; s2 < 2; ++s2) { const u32x4 w = sfr[kt * 2 + s2];
                        d[8 * s2 + 0] = bflo(w.x); d[8 * s2 + 1] = bfhi(w.x); d[8 * s2 + 2] = bflo(w.y); d[8 * s2 + 3] = bfhi(w.y);
                        d[8 * s2 + 4] = bflo(w.z); d[8 * s2 + 5] = bfhi(w.z); d[8 * s2 + 6] = bflo(w.w); d[8 * s2 + 7] = bfhi(w.w); }
#pragma unroll
                    for (int i = 0; i < 16; ++i) d[i] *= decs[kt * 32 + (i & 3) + 8 * (i >> 2) + 4 * hh];
#pragma unroll
                    for (int ks = 0; ks < 4; ++ks) {
                        const bf16x8 af = *(const LAS bf16x8*)(kd + (kt * 32 + r) * 72 + 16 * ks + 8 * hh);
                        const bf16x8 bfr = *(const LAS bf16x8*)(vT + vrow * 72 + VT_GRP(vrow, 2 * ks + hh));
                        d = __builtin_amdgcn_mfma_f32_32x32x16_bf16(af, bfr, d, 0, 0, 0);
                    }
#pragma unroll
                    for (int s2 = 0; s2 < 2; ++s2)
                        sfr[kt * 2 + s2] = (u32x4){cvt_pk_bf16(d[8 * s2 + 0], d[8 * s2 + 1]), cvt_pk_bf16(d[8 * s2 + 2], d[8 * s2 + 3]), cvt_pk_bf16(d[8 * s2 + 4], d[8 * s2 + 5]), cvt_pk_bf16(d[8 * s2 + 6], d[8 * s2 + 7])};
                    __builtin_amdgcn_sched_barrier(0);
                }
            }
            u32x4 psz[2];
            LOAD_TILE2_NT(psz, SZ, un);
            __syncthreads();
#pragma unroll
            for (int i = 0; i < 2; ++i) { const int p = tid + 512 * i, t = p >> 4, vg = p & 15;
                f32x4 o0, o1, z0, z1; unpack8(*(const LAS u32x4*)(ost + t * 136 + vg * 8), o0, o1);
                float ss = (o0[0] * o0[0] + o0[1] * o0[1]) + (o0[2] * o0[2] + o0[3] * o0[3]) + (o1[0] * o1[0] + o1[1] * o1[1]) + (o1[2] * o1[2] + o1[3] * o1[3]);
                ss += __shfl_xor(ss, 1); ss += __shfl_xor(ss, 2); ss += __shfl_xor(ss, 4); ss += __shfl_xor(ss, 8);
                const float rs = rsqrtf(ss * (1.0f / 128.0f) + EPS);
                unpack8(psz[i], z0, z1);
#pragma unroll
                for (int e = 0; e < 4; ++e) { z0[e] = silu_f(z0[e]); z1[e] = silu_f(z1[e]); }
                *(u32x4*)(SZ + (row0 + t) * DM + h * 128 + vg * 8) = pack8(o0 * rs * z0, o1 * rs * z1);
                __builtin_amdgcn_sched_barrier(0); }
        }
        __syncthreads();
    }
    GSYNC();

    {
        { pg8::Gemm g{GA, SZ, BTAB, MP, DM, 2048, DM, 2048, 16}; pg8::StaticOrder S; S.init(MP, DM, G, bid);
          EpiMerge E{SGA, SGB, MG};
          pg8::gemm_phase<EpiMerge, true, true>(lds, g, S, E); }
        { pg8::Gemm gp{PB, nullptr, BTP, MP, DM, DPLE, DPLE, DPLE, 0}; pg8::StaticOrder S2; S2.init(MP, DM, G, bid);
          EpiPP E2{PP}; pg8::gemm_phase<EpiPP, true, true>(lds, gp, S2, E2); }
        for (int tile = bid; tile < 256; tile += G) {
            const int tr = tile >> 3, tc = tile & 7, rbase = MP + tr * 64, cbase = tc * 128;
            const int wr2 = wave >> 2, wc4 = wave & 3, r = lane & 31, hh = lane >> 5;
            const int col = cbase + wc4 * 32 + r;
            {
                f32x16 accP;
#pragma unroll
                for (int i = 0; i < 16; ++i) accP[i] = 0.f;
                accP = mini_gemm(lds, PB + (size_t)rbase * DPLE, DPLE, BTP + (size_t)cbase * DPLE, DPLE, DPLE, tid, wave, lane, accP);
#pragma unroll
                for (int i = 0; i < 16; ++i) { const int row = rbase + wr2 * 32 + (i & 3) + 8 * (i >> 2) + 4 * hh; PP[(size_t)row * DM + col] = f2bf(accP[i]); }
            }
            f32x16 accA, accB;
#pragma unroll
            for (int i = 0; i < 16; ++i) { accA[i] = 0.f; accB[i] = 0.f; }
            accA = mini_gemm(lds, GA + (size_t)rbase * DM, DM, BTAB + (size_t)cbase * 2048, 2048, DM, tid, wave, lane, accA);
            accB = mini_gemm(lds, SZ + (size_t)rbase * DM, DM, BTAB + (size_t)cbase * 2048 + 1024, 2048, DM, tid, wave, lane, accB);
            float ga[16], gb[16];
#pragma unroll
            for (int i = 0; i < 16; ++i) { const int row = rbase + wr2 * 32 + (i & 3) + 8 * (i >> 2) + 4 * hh; const size_t off = (size_t)row * DM + col;
                ga[i] = bf2f(SGA[off]); gb[i] = bf2f(SGB[off]); }
#pragma unroll
            for (int i = 0; i < 16; ++i) { const int row = rbase + wr2 * 32 + (i & 3) + 8 * (i >> 2) + 4 * hh; const size_t off = (size_t)row * DM + col;
                MG[off] = f2bf(ga[i] * accA[i] + gb[i] * accB[i]); }
        }
    }
    GSYNC();

    {
        { pg8::Gemm g{MG, nullptr, BTO, MP, DM, DM, DM, DM, 0}; pg8::StaticOrder S; S.init(MP, DM, G, bid);
          EpiO E{OUTB, SSQ};
          pg8::gemm_phase<EpiO, true, true>(lds, g, S, E); }
        for (int tile = bid; tile < 256; tile += G) {
            const int tr = tile >> 3, tc = tile & 7, rbase = MP + tr * 64, cbase = tc * 128;
            const int wr2 = wave >> 2, wc4 = wave & 3, r = lane & 31, hh = lane >> 5;
            const int col = cbase + wc4 * 32 + r;
            f32x16 acc;
#pragma unroll
            for (int i = 0; i < 16; ++i) acc[i] = 0.f;
            acc = mini_gemm(lds, MG + (size_t)rbase * DM, DM, BTO + (size_t)cbase * DM, DM, DM, tid, wave, lane, acc);
#pragma unroll
            for (int i = 0; i < 16; ++i) { const int row = rbase + wr2 * 32 + (i & 3) + 8 * (i >> 2) + 4 * hh;
                OUTB[(size_t)row * DM + col] = f2bf(acc[i]);
                float s = acc[i] * acc[i];
                s += __shfl_xor(s, 1); s += __shfl_xor(s, 2); s += __shfl_xor(s, 4); s += __shfl_xor(s, 8); s += __shfl_xor(s, 16);
                if (r == 0) SSQ2[(size_t)(row - MP) * 32 + tc * 4 + wc4] = s; }
        }
    }
    GSYNC();

    {
        const f32x4* gr = (const f32x4*)g_post + lane;
        f32x4 gp[4];
#pragma unroll
        for (int j = 0; j < 4; ++j) gp[j] = gr[64 * j];
        for (int m0 = gw; m0 < M_TOK; m0 += 2 * NGW) {
            const int m1 = m0 + NGW; const bool has1 = m1 < M_TOK; const int m1c = has1 ? m1 : m0;
            const f32x4* xr0 = (const f32x4*)((m0 < MP) ? x_p + (size_t)m0 * DM : x_s + (size_t)(m0 - MP) * DM) + lane;
            const f32x4* xr1 = (const f32x4*)((m1c < MP) ? x_p + (size_t)m1c * DM : x_s + (size_t)(m1c - MP) * DM) + lane;
            const u32x2* or0 = (const u32x2*)(OUTB + (size_t)m0 * DM) + lane; const u32x2* or1 = (const u32x2*)(OUTB + (size_t)m1c * DM) + lane;
            float sq0 = (m0 < MP) ? ((lane < 16) ? SSQ[(size_t)m0 * 16 + lane] : 0.f) : ((lane < 32) ? SSQ2[(size_t)(m0 - MP) * 32 + lane] : 0.f);
            float sq1 = (m1c < MP) ? ((lane < 16) ? SSQ[(size_t)m1c * 16 + lane] : 0.f) : ((lane < 32) ? SSQ2[(size_t)(m1c - MP) * 32 + lane] : 0.f);
            f32x4 x0[4], x1[4]; u32x2 w0[4], w1[4];
#pragma unroll
            for (int j = 0; j < 4; ++j) { x0[j] = xr0[64 * j]; x1[j] = xr1[64 * j]; w0[j] = or0[64 * j]; w1[j] = or1[64 * j]; }
            sq0 = wave_sum(sq0); sq1 = wave_sum(sq1);
            const float rs0 = rsqrtf(sq0 * (1.0f / DM) + EPS), rs1 = rsqrtf(sq1 * (1.0f / DM) + EPS);
            float s0 = 0.f, s1 = 0.f;
#pragma unroll
            for (int j = 0; j < 4; ++j) {
                const f32x4 of0 = (f32x4){bflo(w0[j].x), bfhi(w0[j].x), bflo(w0[j].y), bfhi(w0[j].y)}, of1 = (f32x4){bflo(w1[j].x), bfhi(w1[j].x), bflo(w1[j].y), bfhi(w1[j].y)};
                x0[j] = x0[j] + of0 * rs0 * gp[j]; x1[j] = x1[j] + of1 * rs1 * gp[j];
                s0 += (x0[j][0] * x0[j][0] + x0[j][1] * x0[j][1]) + (x0[j][2] * x0[j][2] + x0[j][3] * x0[j][3]);
                s1 += (x1[j][0] * x1[j][0] + x1[j][1] * x1[j][1]) + (x1[j][2] * x1[j][2] + x1[j][3] * x1[j][3]); }
            s0 = wave_sum(s0); s1 = wave_sum(s1);
            if (lane == 0) { R1[m0] = rsqrtf(s0 * (1.0f / DM) + EPS); RINV[m0] = rs0; if (has1) { R1[m1] = rsqrtf(s1 * (1.0f / DM) + EPS); RINV[m1] = rs1; } }
            f32x4* y0 = (f32x4*)(out + O_Y + (size_t)m0 * DM) + lane; u32x2* b0 = (u32x2*)(X1B + (size_t)m0 * DM) + lane;
#pragma unroll
            for (int j = 0; j < 4; ++j) { if (m0 >= MP) y0[64 * j] = x0[j];
                u32x2 w; w.x = cvt_pk_bf16(x0[j][0], x0[j][1]); w.y = cvt_pk_bf16(x0[j][2], x0[j][3]); b0[64 * j] = w; }
            if (has1) {
                f32x4* y1 = (f32x4*)(out + O_Y + (size_t)m1 * DM) + lane; u32x2* b1 = (u32x2*)(X1B + (size_t)m1 * DM) + lane;
#pragma unroll
                for (int j = 0; j < 4; ++j) { if (m1 >= MP) y1[64 * j] = x1[j];
                    u32x2 w; w.x = cvt_pk_bf16(x1[j][0], x1[j][1]); w.y = cvt_pk_bf16(x1[j][2], x1[j][3]); b1[64 * j] = w; }
            }
        }
    }
    GSYNC();

    {
        pg8::StaticOrder S; S.init(M_TOK, DM, G, bid);
        { pg8::Gemm g{X1B, nullptr, BTG, MP, DM, DM, DM, DM, 0}; pg8::StaticOrder Sp; Sp.init(MP, DM, G, bid); EpiFinal E{R1, RINV  , PP, OUTB, x_p, g_post, out + O_Y}; pg8::gemm_phase<EpiFinal, true, true>(lds, g, Sp, E); }
        for (int tile = bid; tile < 256; tile += G) {
            const int tr = tile >> 3, tc = tile & 7, rbase = MP + tr * 64, cbase = tc * 128;
            f32x16 acc;
#pragma unroll
            for (int i = 0; i < 16; ++i) acc[i] = 0.f;
            acc = mini_gemm(lds, X1B + (size_t)rbase * DM, DM, BTG + (size_t)cbase * DM, DM, DM, tid, wave, lane, acc);
            const int wr2 = wave >> 2, wc4 = wave & 3, r = lane & 31, hh = lane >> 5;
            const int col = cbase + wc4 * 32 + r;
            float yv[16], pv2[16], rv[16];
#pragma unroll
            for (int i = 0; i < 16; ++i) { const int row = rbase + wr2 * 32 + (i & 3) + 8 * (i >> 2) + 4 * hh; const size_t off = (size_t)row * DM + col;
                yv[i] = out[O_Y + off]; pv2[i] = bf2f(PP[off]); rv[i] = R1[row]; }
#pragma unroll
            for (int i = 0; i < 16; ++i) { const int row = rbase + wr2 * 32 + (i & 3) + 8 * (i >> 2) + 4 * hh; const size_t off = (size_t)row * DM + col;
                out[O_Y + off] = yv[i] + pv2[i] * sigmoid_f(acc[i] * rv[i]); }
        }
    }
}

extern "C" void kernel_launch(void* const* d_in, const int* in_sizes, int n_in, void* d_out, int out_size, void* d_ws, size_t ws_size, hipStream_t stream) {
    static int grid_blocks = 0;
    if (grid_blocks == 0) {
        if (n_in != 18 || (size_t)out_size != O_TOTAL || ws_size < WS_END) { fprintf(stderr, "kernel_launch: unexpected shapes (n_in %d out %d ws %zu)\n", n_in, out_size, ws_size); grid_blocks = -1; return; }
        int dev = 0, cus = 0, per_cu = 0;
        hipGetDevice(&dev);
        hipDeviceGetAttribute(&cus, hipDeviceAttributeMultiprocessorCount, dev);
        hipFuncSetAttribute((const void*)fwd_kernel, hipFuncAttributeMaxDynamicSharedMemorySize, LDS_BYTES);
        hipOccupancyMaxActiveBlocksPerMultiprocessor(&per_cu, (const void*)fwd_kernel, 512, LDS_BYTES);
        if (per_cu < 1) { fprintf(stderr, "kernel_launch: occupancy query says %d blocks per CU\n", per_cu); grid_blocks = -1; return; }
        grid_blocks = cus * per_cu;
    }
    if (grid_blocks < 0) return;
    if (hipMemsetAsync((char*)d_ws + WS_BAR, 0, XCD_BAR_WORDS * 4, stream) != hipSuccess) { fprintf(stderr, "kernel_launch: memset of barrier words failed\n"); return; }
    Args a{};
    for (int i = 0; i < 18; ++i) a.in[i] = (const float*)d_in[i];
    a.out = (float*)d_out; a.ws = (unsigned char*)d_ws;
    void* args[] = {&a};
    hipError_t e = hipLaunchCooperativeKernel((const void*)fwd_kernel, dim3(grid_blocks), dim3(512), args, LDS_BYTES, stream);
    if (e != hipSuccess) fprintf(stderr, "cooperative launch failed: %s (grid %d)\n", hipGetErrorString(e), grid_blocks);
}
```

```cpp
#include <hip/hip_runtime.h>
#include <cstdio>
#include <cstdint>
#include <cstddef>

#define LAS __attribute__((address_space(3)))
typedef unsigned short bf16_t;
typedef short bf16x8 __attribute__((ext_vector_type(8)));
typedef short s16x4 __attribute__((ext_vector_type(4)));
typedef float f32x4 __attribute__((ext_vector_type(4)));
typedef float f32x16 __attribute__((ext_vector_type(16)));
typedef unsigned u32x4 __attribute__((ext_vector_type(4)));
typedef unsigned u32x2 __attribute__((ext_vector_type(2)));

constexpr int M_TOK = 34816;
constexpr int MP = 32768;
constexpr int DM = 1024;
constexpr int NIN = 10240;
constexpr int DPLE = 256;
constexpr float EPS = 1e-6f;
constexpr float QK_SCALE = 0.08838834764831845f;
constexpr int NCHUNK = M_TOK / 64;
constexpr int NCHUNK_P = MP / 64;

typedef float f32x2_t __attribute__((ext_vector_type(2))); typedef __bf16 bf16x2_t __attribute__((ext_vector_type(2)));
__device__ __forceinline__ unsigned cvt_pk_bf16(float lo, float hi) { f32x2_t v = {lo, hi}; bf16x2_t b = __builtin_convertvector(v, bf16x2_t); return __builtin_bit_cast(unsigned, b); }
__device__ __forceinline__ float bf2f(unsigned short b) { return __uint_as_float((unsigned)b << 16); }
__device__ __forceinline__ float bflo(unsigned w) { return __uint_as_float(w << 16); }
__device__ __forceinline__ float bfhi(unsigned w) { return __uint_as_float(w & 0xffff0000u); }
__device__ __forceinline__ unsigned short f2bf(float f) { unsigned u = __float_as_uint(f); return (unsigned short)((u + 0x7fffu + ((u >> 16) & 1u)) >> 16); }
__device__ __forceinline__ float sigmoid_f(float x) { return __builtin_amdgcn_rcpf(1.0f + __expf(-x)); }
__device__ __forceinline__ float silu_f(float x) { return x * sigmoid_f(x); }
__device__ __forceinline__ unsigned short f2h(float f) { _Float16 h = (_Float16)f; return __builtin_bit_cast(unsigned short, h); }
__device__ __forceinline__ float h2f(unsigned short u) { return (float)__builtin_bit_cast(_Float16, u); }
__device__ __forceinline__ float wave_sum(float v) {
#pragma unroll
    for (int o = 1; o < 64; o <<= 1) v += __shfl_xor(v, o);
    return v;
}
#define LDS_WAIT() asm volatile("s_waitcnt lgkmcnt(0)" ::: "memory")
__device__ __forceinline__ int launder(int x) { asm volatile("" : "+v"(x)); return x; }

namespace pg8 {
constexpr int BM = 256, BK = 64, HALF = 128, HTB = HALF * BK * 2, STAGE_BYTES = 8 * HTB, NXCD = 8, WGM = 8;
__host__ __device__ __forceinline__ int lds_byte(int r, int c) { const int st = (r >> 4) * 2 + (c >> 5), rr = r & 15, cc = c & 31, ob = rr * 64 + cc * 2; return st * 1024 + (ob ^ (((ob >> 9) & 1) << 5)); }
__host__ __device__ __forceinline__ void stage_rc(int b, int& R, int& C) { const int st = b / 1024, sb = b % 1024, swz = sb ^ (((sb >> 9) & 1) << 5); R = (st >> 1) * 16 + swz / 64; C = (st & 1) * 32 + (swz % 64) / 2; }
__host__ __device__ __forceinline__ int perm32(int rho) { const int n = rho >> 4, i = rho & 15; return 8 * (i >> 2) + 4 * n + (i & 3); }

struct Unit { int pm, pn; };
struct Gemm { const bf16_t* A; const bf16_t* A2; const bf16_t* Bt; int M, N, K, lda, ldb, kseg; };

struct StaticOrder {
    int nM, nN, nwg, G, c;
    __host__ __device__ void init(int M, int N, int G_, int c_) { nM = M / BM; nN = N / BM; nwg = nM * nN; G = G_; c = c_; }
    __host__ __device__ bool next(int i, Unit& u) const {
        const long L = (long)i * G + c; if (L >= nwg) return false;
        int wgid = (int)L; { const int q = nwg / NXCD, r = nwg % NXCD, xcd = wgid % NXCD, off = wgid / NXCD; wgid = (xcd < r ? xcd * (q + 1) : r * (q + 1) + (xcd - r) * q) + off; }
        const int nig = WGM * nN, gid = wgid / nig, fm = gid * WGM, gsz = (nM - fm) < WGM ? (nM - fm) : WGM;
        u.pm = fm + ((wgid % nig) % gsz); u.pn = (wgid % nig) / gsz; return true;
    }
};

template <class Epi, bool ALIGN_EPI, bool SP2>
__device__ __forceinline__ void gemm_phase(LAS unsigned char* lds, const Gemm g, const StaticOrder& S, const Epi& E) {
    const int tid = launder((int)threadIdx.x), wid = __builtin_amdgcn_readfirstlane(tid >> 6), lane = tid & 63, wr = wid >> 2, wc = wid & 3, fr = lane & 15, fq = lane >> 4;
    const int K = g.K, nt = K / BK;
    unsigned voffA[2], voffB[2];
#pragma unroll
    for (int i = 0; i < 2; ++i) { int R, C; stage_rc(tid * 16 + i * 8192, R, C); const int Rb = (R & ~31) + perm32(R & 31);
        voffA[i] = (unsigned)(R * g.lda + C) * 2u; voffB[i] = (unsigned)(Rb * g.ldb + C) * 2u; }
    const size_t kstep = (size_t)(BK * 2);
    const size_t hstepA = (size_t)HALF * g.lda * 2, hstepB = (size_t)HALF * g.ldb * 2;
    const size_t tstepA = 2 * hstepA, tstepB = 2 * hstepB;
    const ptrdiff_t segd = g.A2 ? (((const char*)g.A2 - (const char*)g.A) - (ptrdiff_t)g.kseg * (ptrdiff_t)kstep) : (ptrdiff_t)0;
    const int kseg = g.A2 ? g.kseg : (nt + 8);
    const unsigned ldsw = (unsigned)wid * 1024u;
    const int aoff = lds_byte(wr * 64 + fr, fq * 8), boff = lds_byte(wc * 32 + fr, fq * 8);
#define PG8_SA(b, h) (((b) * 2 + (h)) * HTB)
#define PG8_SB(b, h) ((4 + (b) * 2 + (h)) * HTB)
#define PG8_STAGE(bufoff, gbase, voff) do { _Pragma("unroll") for (int _i = 0; _i < 2; ++_i) \
        __builtin_amdgcn_global_load_lds((const unsigned*)((const char*)(gbase) + (voff)[_i]), (LAS unsigned*)(lds + (bufoff) + ldsw + _i * 8192), 16, 0, 0); } while (0)
#define PG8_LDA(dst, b, h) do { _Pragma("unroll") for (int m = 0; m < 4; ++m) _Pragma("unroll") for (int k = 0; k < 2; ++k) dst[m][k] = *(const LAS bf16x8*)(lds + PG8_SA(b, h) + aoff + m * 2048 + k * 1024); } while (0)
#define PG8_LDB(dst, b, h) do { _Pragma("unroll") for (int n = 0; n < 2; ++n) _Pragma("unroll") for (int k = 0; k < 2; ++k) dst[n][k] = *(const LAS bf16x8*)(lds + PG8_SB(b, h) + boff + n * 2048 + k * 1024); } while (0)
#define PG8_MMA(ai, bj, At, Bt) do { __builtin_amdgcn_s_setprio(1); _Pragma("unroll") for (int m = 0; m < 4; ++m) _Pragma("unroll") for (int n = 0; n < 2; ++n) _Pragma("unroll") for (int k = 0; k < 2; ++k) \
        acc[ai][bj][m][n] = __builtin_amdgcn_mfma_f32_16x16x32_bf16(Bt[n][k], At[m][k], acc[ai][bj][m][n], 0, 0, 0); __builtin_amdgcn_s_setprio(0); } while (0)
#define PG8_WAIT_V(n) asm volatile("s_waitcnt vmcnt(" #n ")" ::: "memory")
#define PG8_WAIT_L(n) asm volatile("s_waitcnt lgkmcnt(" #n ")" ::: "memory")
#define PG8_BAR __builtin_amdgcn_s_barrier()
#define PG8_SCHED __builtin_amdgcn_sched_barrier(0)
    Unit cur, nxt; int ui = 0;
    if (!S.next(0, cur)) return;
    f32x4 acc[2][2][4][2];
#pragma unroll
    for (int a = 0; a < 2; ++a)
#pragma unroll
        for (int b = 0; b < 2; ++b)
#pragma unroll
            for (int m = 0; m < 4; ++m)
#pragma unroll
                for (int n = 0; n < 2; ++n) acc[a][b][m][n] = (f32x4){0.f, 0.f, 0.f, 0.f};
    bf16x8 At[4][2], B0[2][2], B1[2][2];
    const char* cA = (const char*)g.A + (size_t)cur.pm * tstepA; const char* cB = (const char*)g.Bt + (size_t)cur.pn * tstepB;
    if constexpr (SP2) {
        PG8_STAGE(PG8_SB(0, 0), cB, voffB); PG8_STAGE(PG8_SB(0, 1), cB + hstepB, voffB); PG8_STAGE(PG8_SA(0, 0), cA, voffA); PG8_STAGE(PG8_SA(0, 1), cA + hstepA, voffA);
        if (wr == 1) PG8_BAR;
        PG8_WAIT_V(2); PG8_BAR;
        PG8_STAGE(PG8_SB(1, 0), cB + kstep, voffB); PG8_STAGE(PG8_SA(1, 0), cA + kstep, voffA); PG8_STAGE(PG8_SB(1, 1), cB + hstepB + kstep, voffB);
        PG8_WAIT_V(6); PG8_BAR;
    } else {
        PG8_STAGE(PG8_SB(0, 0), cB, voffB); PG8_STAGE(PG8_SA(0, 0), cA, voffA); PG8_STAGE(PG8_SB(0, 1), cB + hstepB, voffB); PG8_STAGE(PG8_SA(0, 1), cA + hstepA, voffA);
        if (wr == 1) PG8_BAR;
        PG8_WAIT_V(4); PG8_BAR;
        PG8_STAGE(PG8_SB(1, 0), cB + kstep, voffB); PG8_STAGE(PG8_SA(1, 0), cA + kstep, voffA); PG8_STAGE(PG8_SB(1, 1), cB + hstepB + kstep, voffB);
        PG8_WAIT_V(6); PG8_BAR;
    }
    for (;;) {
        const bool has_next = S.next(ui + 1, nxt);
        const char* nA = has_next ? (const char*)g.A + (size_t)nxt.pm * tstepA : cA; const char* nB = has_next ? (const char*)g.Bt + (size_t)nxt.pn * tstepB : cB;
#pragma nounroll
        for (int t = 0; t < nt; t += 2) {
            if constexpr (Epi::HAS_MID) { if (t == kseg) E.mid(acc, cur, wr, wc, fr, fq); }
            const bool last = (t == nt - 2);
            const char* a1 = cA + (size_t)(t + 1) * kstep + ((t + 1) >= kseg ? segd : (ptrdiff_t)0);
            const char* a2 = last ? nA : cA + (size_t)(t + 2) * kstep + ((t + 2) >= kseg ? segd : (ptrdiff_t)0);
            const char* b2 = last ? nB : cB + (size_t)(t + 2) * kstep;
            const char* a3 = a2 + kstep; const char* b3 = b2 + kstep;
            if constexpr (SP2) {
            PG8_LDB(B0, 0, 0); PG8_LDB(B1, 0, 1); PG8_SCHED; PG8_LDA(At, 0, 0); PG8_STAGE(PG8_SA(1, 1), a1 + hstepA, voffA);
            PG8_WAIT_V(8); PG8_WAIT_L(0); PG8_BAR; PG8_MMA(0, 0, At, B0); PG8_MMA(0, 1, At, B1); PG8_BAR; PG8_SCHED;
            PG8_LDA(At, 0, 1); PG8_STAGE(PG8_SB(0, 0), b2, voffB); PG8_STAGE(PG8_SB(0, 1), b2 + hstepB, voffB); PG8_STAGE(PG8_SA(0, 0), a2, voffA);
            PG8_WAIT_V(8); PG8_WAIT_L(0); PG8_BAR; PG8_MMA(1, 0, At, B0); PG8_MMA(1, 1, At, B1); PG8_BAR; PG8_SCHED;
            PG8_LDB(B0, 1, 0); PG8_LDB(B1, 1, 1); PG8_SCHED; PG8_LDA(At, 1, 0); PG8_STAGE(PG8_SA(0, 1), a2 + hstepA, voffA);
            PG8_WAIT_V(8); PG8_WAIT_L(0); PG8_BAR; PG8_MMA(0, 0, At, B0); PG8_MMA(0, 1, At, B1); PG8_BAR; PG8_SCHED;
            PG8_LDA(At, 1, 1); PG8_STAGE(PG8_SB(1, 0), b3, voffB); PG8_STAGE(PG8_SB(1, 1), b3 + hstepB, voffB); PG8_STAGE(PG8_SA(1, 0), a3, voffA);
            PG8_WAIT_V(8); PG8_WAIT_L(0); PG8_BAR; PG8_MMA(1, 0, At, B0); PG8_MMA(1, 1, At, B1); PG8_BAR; PG8_SCHED;
            } else {
            PG8_LDB(B0, 0, 0); PG8_SCHED; PG8_LDA(At, 0, 0); PG8_STAGE(PG8_SA(1, 1), a1 + hstepA, voffA);
            PG8_WAIT_L(8); PG8_BAR; PG8_WAIT_L(0); PG8_MMA(0, 0, At, B0); PG8_BAR; PG8_SCHED;
            PG8_LDB(B1, 0, 1); PG8_STAGE(PG8_SB(0, 0), b2, voffB);
            PG8_BAR; PG8_WAIT_L(0); PG8_MMA(0, 1, At, B1); PG8_BAR;
            PG8_LDA(At, 0, 1); PG8_STAGE(PG8_SA(0, 0), a2, voffA);
            PG8_BAR; PG8_WAIT_L(0); PG8_MMA(1, 0, At, B0); PG8_BAR; PG8_SCHED;
            PG8_STAGE(PG8_SB(0, 1), b2 + hstepB, voffB);
            PG8_WAIT_V(6); PG8_BAR; PG8_MMA(1, 1, At, B1); PG8_BAR;
            PG8_LDB(B0, 1, 0); PG8_SCHED; PG8_LDA(At, 1, 0); PG8_STAGE(PG8_SA(0, 1), a2 + hstepA, voffA);
            PG8_WAIT_L(8); PG8_BAR; PG8_WAIT_L(0); PG8_MMA(0, 0, At, B0); PG8_BAR; PG8_SCHED;
            PG8_LDB(B1, 1, 1); PG8_STAGE(PG8_SB(1, 0), b3, voffB);
            PG8_BAR; PG8_WAIT_L(0); PG8_MMA(0, 1, At, B1); PG8_BAR;
            PG8_LDA(At, 1, 1); PG8_STAGE(PG8_SA(1, 0), a3, voffA);
            PG8_BAR; PG8_WAIT_L(0); PG8_MMA(1, 0, At, B0); PG8_BAR; PG8_SCHED;
            PG8_STAGE(PG8_SB(1, 1), b3 + hstepB, voffB);
            PG8_WAIT_V(6); PG8_BAR; PG8_MMA(1, 1, At, B1); PG8_BAR;
            }
        }
        if constexpr (ALIGN_EPI) { if (wr == 0) PG8_BAR; }
        E(acc, cur, wr, wc, fr, fq);
        if (!has_next) break;
#pragma unroll
        for (int a = 0; a < 2; ++a)
#pragma unroll
            for (int b = 0; b < 2; ++b)
#pragma unroll
                for (int m = 0; m < 4; ++m)
#pragma unroll
                    for (int n = 0; n < 2; ++n) acc[a][b][m][n] = (f32x4){0.f, 0.f, 0.f, 0.f};
        cur = nxt; cA = nA; cB = nB; ++ui;
        if constexpr (ALIGN_EPI) { if (wr == 1) PG8_BAR; }
    }
    PG8_WAIT_V(0);
    if constexpr (!ALIGN_EPI) { if (wr == 0) PG8_BAR; }
    PG8_BAR;
#undef PG8_SA
#undef PG8_SB
#undef PG8_STAGE
#undef PG8_LDA
#undef PG8_LDB
#undef PG8_MMA
#undef PG8_WAIT_V
#undef PG8_WAIT_L
#undef PG8_BAR
#undef PG8_SCHED
}
}

__device__ __forceinline__ u32x4 pack8(const f32x4 a, const f32x4 b) { u32x4 w; w.x = cvt_pk_bf16(a[0], a[1]); w.y = cvt_pk_bf16(a[2], a[3]); w.z = cvt_pk_bf16(b[0], b[1]); w.w = cvt_pk_bf16(b[2], b[3]); return w; }
__device__ __forceinline__ void unpack8(const u32x4 w, f32x4& a, f32x4& b) { a = (f32x4){bflo(w.x), bfhi(w.x), bflo(w.y), bfhi(w.y)}; b = (f32x4){bflo(w.z), bfhi(w.z), bflo(w.w), bfhi(w.w)}; }

struct Epi1 {
    static constexpr bool HAS_MID = false;
    const float* rinv; const float* lbv;
    bf16_t *UF, *GA, *Q, *V, *SZ, *SGA, *SGB; unsigned short* LFH; float* conv_p; float* conv_s; const float* convw; LAS unsigned char* ldsx;
    __device__ __forceinline__ void operator()(const f32x4 (&acc)[2][2][4][2], const pg8::Unit& u, int wr, int wc, int fr, int fq) const {
        const int row0 = launder(u.pm * 256 + wr * 64 + fr);
        float rv[2][4];
#pragma unroll
        for (int ai = 0; ai < 2; ++ai)
#pragma unroll
            for (int m = 0; m < 4; ++m) rv[ai][m] = rinv[row0 + ai * 128 + m * 16];
        if (u.pn < 16) {
            const int c4 = launder(u.pn * 64 + wc * 16 + 4 * fq);
            const f32x4 w0 = *(const f32x4*)(convw + c4), w1 = *(const f32x4*)(convw + DM + c4), w2 = *(const f32x4*)(convw + 2 * DM + c4);
            LAS unsigned short* wl = (LAS unsigned short*)(ldsx + (wr * 4 + wc) * 2048);
#pragma unroll
            for (int ai = 0; ai < 2; ++ai) {
                f32x4 uu[4], gg[4];
#pragma unroll
                for (int m = 0; m < 4; ++m) {
                    const int row = row0 + ai * 128 + m * 16; const float r = rv[ai][m]; const float r2 = r * r;
                    uu[m] = acc[ai][0][m][0] * acc[ai][0][m][1] * r2;
#pragma unroll
                    for (int e = 0; e < 4; ++e) gg[m][e] = silu_f(acc[ai][1][m][1][e] * r) * (acc[ai][1][m][0][e] * r);
                    float* cdst = nullptr;
                    if (row < MP) { const int t = row & 8191; if (t >= 8190) cdst = conv_p + ((size_t)((row >> 13) * 2 + (t - 8190))) * DM + c4; }
                    else { const int rs = row - MP; const int t = rs & 63; if (t >= 62) cdst = conv_s + ((size_t)((rs >> 6) * 2 + (t - 62))) * DM + c4; }
                    if (cdst) *(f32x4*)cdst = uu[m];
                    u32x2 w; w.x = cvt_pk_bf16(uu[m][0], uu[m][1]); w.y = cvt_pk_bf16(uu[m][2], uu[m][3]);
                    *(LAS u32x2*)(wl + (16 * m + fr) * 16 + 4 * fq) = w;
                    if ((m == 0 && fr < 2) || (m == 3 && fr >= 14)) { const int slot = (m == 0) ? fr : (fr - 12);
                        *(u32x2*)(UF + ((size_t)(row >> 6) * 4 + slot) * DM + c4) = w; }
                }
                LDS_WAIT(); asm volatile("" ::: "memory");
#pragma unroll
                for (int m = 0; m < 4; ++m) {
                    const int row = row0 + ai * 128 + m * 16; const int lr = 16 * m + fr;
                    f32x4 res = gg[m];
                    if (lr >= 2) {
                        const u32x2 a1 = *(const LAS u32x2*)(wl + (lr - 1) * 16 + 4 * fq), a2 = *(const LAS u32x2*)(wl + (lr - 2) * 16 + 4 * fq);
                        const f32x4 um1 = (f32x4){bflo(a1.x), bfhi(a1.x), bflo(a1.y), bfhi(a1.y)}, um2 = (f32x4){bflo(a2.x), bfhi(a2.x), bflo(a2.y), bfhi(a2.y)};
                        res = gg[m] * (w0 * um2 + w1 * um1 + w2 * uu[m]);
                    }
                    u32x2 w; w.x = cvt_pk_bf16(res[0], res[1]); w.y = cvt_pk_bf16(res[2], res[3]);
                    *(u32x2*)(GA + (size_t)row * DM + c4) = w;
                }
                LDS_WAIT(); asm volatile("" ::: "memory");
            }
            return;
        }
        const int type = 2 + ((u.pn - 16) >> 3);
        const int ch0 = launder(((u.pn - 16) & 7) * 128 + wc * 32 + 8 * fq);
        if (type == 2) {
            const f32x4 lb0 = *(const f32x4*)(lbv + ch0), lb1 = *(const f32x4*)(lbv + ch0 + 4);
#pragma unroll
            for (int ai = 0; ai < 2; ++ai)
#pragma unroll
                for (int m = 0; m < 4; ++m) {
                    const int row = row0 + ai * 128 + m * 16; const float r = rv[ai][m];
                    f32x4 q0, q1; unsigned short lf[8];
#pragma unroll
                    for (int i = 0; i < 4; ++i) {
                        q0[i] = acc[ai][0][m][0][i] * r; q1[i] = acc[ai][0][m][1][i] * r;
                        const float f0 = lb0[i] + (1.0f - lb0[i]) * sigmoid_f(acc[ai][1][m][0][i] * r), f1 = lb1[i] + (1.0f - lb1[i]) * sigmoid_f(acc[ai][1][m][1][i] * r);
                        lf[i] = f2h(__logf(f0)); lf[4 + i] = f2h(__logf(f1));
                    }
                    *(u32x4*)(Q + (size_t)row * DM + ch0) = pack8(q0, q1);
                    u32x4 w; w.x = (unsigned)lf[0] | ((unsigned)lf[1] << 16); w.y = (unsigned)lf[2] | ((unsigned)lf[3] << 16); w.z = (unsigned)lf[4] | ((unsigned)lf[5] << 16); w.w = (unsigned)lf[6] | ((unsigned)lf[7] << 16);
                    *(u32x4*)(LFH + (size_t)row * DM + ch0) = w;
                }
        } else if (type == 3) {
#pragma unroll
            for (int ai = 0; ai < 2; ++ai)
#pragma unroll
                for (int m = 0; m < 4; ++m) {
                    const int row = row0 + ai * 128 + m * 16; const float r = rv[ai][m];
                    f32x4 z0, z1;
#pragma unroll
                    for (int i = 0; i < 4; ++i) { z0[i] = acc[ai][1][m][0][i] * r; z1[i] = acc[ai][1][m][1][i] * r; }
                    *(u32x4*)(V + (size_t)row * DM + ch0) = pack8(acc[ai][0][m][0] * r, acc[ai][0][m][1] * r);
                    *(u32x4*)(SZ + (size_t)row * DM + ch0) = pack8(z0, z1);
                }
        } else {
#pragma unroll
            for (int ai = 0; ai < 2; ++ai)
#pragma unroll
                for (int m = 0; m < 4; ++m) {
                    const int row = row0 + ai * 128 + m * 16; const float r = rv[ai][m];
                    f32x4 a0, a1, b0, b1;
#pragma unroll
                    for (int i = 0; i < 4; ++i) { a0[i] = sigmoid_f(acc[ai][0][m][0][i] * r); a1[i] = sigmoid_f(acc[ai][0][m][1][i] * r); b0[i] = sigmoid_f(acc[ai][1][m][0][i] * r); b1[i] = sigmoid_f(acc[ai][1][m][1][i] * r); }
                    *(u32x4*)(SGA + (size_t)row * DM + ch0) = pack8(a0, a1);
                    *(u32x4*)(SGB + (size_t)row * DM + ch0) = pack8(b0, b1);
                }
        }
    }
};

struct EpiMerge {
    static constexpr bool HAS_MID = true;
    const bf16_t *SGA, *SGB; bf16_t* MG;
    __device__ __forceinline__ void mid(f32x4 (&acc)[2][2][4][2], const pg8::Unit& u, int wr, int wc, int fr, int fq) const {
        const int row0 = launder(u.pm * 256 + wr * 64 + fr), colb = launder(u.pn * 256 + wc * 32 + 8 * fq);
#pragma unroll
        for (int ai = 0; ai < 2; ++ai) {
            u32x4 la[4][2], lb[4][2];
#pragma unroll
            for (int m = 0; m < 4; ++m)
#pragma unroll
                for (int bj = 0; bj < 2; ++bj) { const size_t off = (size_t)(row0 + ai * 128 + m * 16) * DM + colb + bj * 128;
                    la[m][bj] = __builtin_nontemporal_load((const u32x4*)(SGA + off)); lb[m][bj] = *(const u32x4*)(SGB + off); }
#pragma unroll
            for (int m = 0; m < 4; ++m)
#pragma unroll
                for (int bj = 0; bj < 2; ++bj) {
                    f32x4 a0, a1, b0, b1; unpack8(la[m][bj], a0, a1); unpack8(lb[m][bj], b0, b1);
#pragma unroll
                    for (int i = 0; i < 4; ++i) { acc[ai][bj][m][0][i] *= a0[i] * __builtin_amdgcn_rcpf(b0[i]); acc[ai][bj][m][1][i] *= a1[i] * __builtin_amdgcn_rcpf(b1[i]); }
                }
            asm volatile("" : "+v"(acc[ai][0][0][0]), "+v"(acc[ai][1][3][1]) :: "memory");
        }
    }
    __device__ __forceinline__ void operator()(const f32x4 (&acc)[2][2][4][2], const pg8::Unit& u, int wr, int wc, int fr, int fq) const {
        const int row0 = launder(u.pm * 256 + wr * 64 + fr), colb = launder(u.pn * 256 + wc * 32 + 8 * fq);
#pragma unroll
        for (int ai = 0; ai < 2; ++ai) {
            u32x4 lb[4][2];
#pragma unroll
            for (int m = 0; m < 4; ++m)
#pragma unroll
                for (int bj = 0; bj < 2; ++bj) lb[m][bj] = __builtin_nontemporal_load((const u32x4*)(SGB + (size_t)(row0 + ai * 128 + m * 16) * DM + colb + bj * 128));
#pragma unroll
            for (int m = 0; m < 4; ++m)
#pragma unroll
                for (int bj = 0; bj < 2; ++bj) { const size_t off = (size_t)(row0 + ai * 128 + m * 16) * DM + colb + bj * 128;
                    f32x4 b0, b1; unpack8(lb[m][bj], b0, b1);
                    *(u32x4*)(MG + off) = pack8(acc[ai][bj][m][0] * b0, acc[ai][bj][m][1] * b1); }
            asm volatile("" ::: "memory");
        }
    }
};

struct EpiO {
    static constexpr bool HAS_MID = false;
    bf16_t* OUT; float* SSQ;
    __device__ __forceinline__ void operator()(const f32x4 (&acc)[2][2][4][2], const pg8::Unit& u, int wr, int wc, int fr, int fq) const {
        const int row0 = launder(u.pm * 256 + wr * 64 + fr), colb = launder(u.pn * 256 + wc * 32 + 8 * fq);
#pragma unroll
        for (int ai = 0; ai < 2; ++ai)
#pragma unroll
            for (int m = 0; m < 4; ++m) {
                const int row = row0 + ai * 128 + m * 16; float s = 0.f;
#pragma unroll
                for (int bj = 0; bj < 2; ++bj) {
                    const f32x4 v0 = acc[ai][bj][m][0], v1 = acc[ai][bj][m][1];
                    *(u32x4*)(OUT + (size_t)row * DM + colb + bj * 128) = pack8(v0, v1);
                    s += (v0[0] * v0[0] + v0[1] * v0[1]) + (v0[2] * v0[2] + v0[3] * v0[3]) + (v1[0] * v1[0] + v1[1] * v1[1]) + (v1[2] * v1[2] + v1[3] * v1[3]);
                }
                s += __shfl_xor(s, 16); s += __shfl_xor(s, 32);
                if (fq == 0) SSQ[(size_t)row * 16 + u.pn * 4 + wc] = s;
            }
    }
};

struct EpiPP {
    static constexpr bool HAS_MID = false;
    bf16_t* PP;
    __device__ __forceinline__ void operator()(const f32x4 (&acc)[2][2][4][2], const pg8::Unit& u, int wr, int wc, int fr, int fq) const {
        const int row0 = launder(u.pm * 256 + wr * 64 + fr), colb = launder(u.pn * 256 + wc * 32 + 8 * fq);
#pragma unroll
        for (int ai = 0; ai < 2; ++ai)
#pragma unroll
            for (int m = 0; m < 4; ++m)
#pragma unroll
                for (int bj = 0; bj < 2; ++bj) {
                    const size_t off = (size_t)(row0 + ai * 128 + m * 16) * DM + colb + bj * 128;
                    *(u32x4*)(PP + off) = pack8(acc[ai][bj][m][0], acc[ai][bj][m][1]);
                }
    }
};

struct EpiFinal {
    static constexpr bool HAS_MID = false;
    const float* R1; const float* RS; const bf16_t* PP; const bf16_t* OUT; const float* X; const float* gpost; float* Y;
    __device__ __forceinline__ void operator()(const f32x4 (&acc)[2][2][4][2], const pg8::Unit& u, int wr, int wc, int fr, int fq) const {
        const int row0 = launder(u.pm * 256 + wr * 64 + fr), colb = launder(u.pn * 256 + wc * 32 + 8 * fq);
        f32x4 g[2][2];
#pragma unroll
        for (int bj = 0; bj < 2; ++bj) { g[bj][0] = *(const f32x4*)(gpost + colb + bj * 128); g[bj][1] = *(const f32x4*)(gpost + colb + bj * 128 + 4); }
#pragma unroll
        for (int ai = 0; ai < 2; ++ai)
#pragma unroll
            for (int mp = 0; mp < 2; ++mp) {
                u32x4 lp[2][2], lo[2][2]; f32x4 lx[2][2][2]; float rr[2], rsv[2];
#pragma unroll
                for (int mm = 0; mm < 2; ++mm) { const int row = row0 + ai * 128 + (2 * mp + mm) * 16; rr[mm] = R1[row]; rsv[mm] = RS[row];
#pragma unroll
                    for (int bj = 0; bj < 2; ++bj) { const size_t off = (size_t)row * DM + colb + bj * 128;
                        lp[mm][bj] = __builtin_nontemporal_load((const u32x4*)(PP + off)); lo[mm][bj] = __builtin_nontemporal_load((const u32x4*)(OUT + off));
                        lx[mm][bj][0] = __builtin_nontemporal_load((const f32x4*)(X + off)); lx[mm][bj][1] = __builtin_nontemporal_load((const f32x4*)(X + off + 4)); } }
#pragma unroll
                for (int mm = 0; mm < 2; ++mm) { const int m = 2 * mp + mm; const int row = row0 + ai * 128 + m * 16; const float r = rr[mm], rs = rsv[mm];
#pragma unroll
                    for (int bj = 0; bj < 2; ++bj) { const size_t off = (size_t)row * DM + colb + bj * 128;
                        f32x4 p0, p1, o0, o1; unpack8(lp[mm][bj], p0, p1); unpack8(lo[mm][bj], o0, o1);
                        f32x4 y0 = lx[mm][bj][0] + o0 * rs * g[bj][0], y1 = lx[mm][bj][1] + o1 * rs * g[bj][1];
#pragma unroll
                        for (int i = 0; i < 4; ++i) { y0[i] += p0[i] * sigmoid_f(acc[ai][bj][m][0][i] * r); y1[i] += p1[i] * sigmoid_f(acc[ai][bj][m][1][i] * r); }
                        __builtin_nontemporal_store(y0, (f32x4*)(Y + off)); __builtin_nontemporal_store(y1, (f32x4*)(Y + off + 4)); } }
                asm volatile("" ::: "memory");
            }
    }
};

constexpr size_t MiB = 1u << 20;
constexpr size_t BUF = (size_t)M_TOK * DM * 2;
constexpr size_t WS_GA = 0, WS_Q = 68 * MiB, WS_LFH = 136 * MiB, WS_V = 204 * MiB, WS_SZ = 272 * MiB, WS_U = 340 * MiB, WS_XB = 408 * MiB, WS_BTIN = 476 * MiB;
constexpr size_t WS_BTAB = 496 * MiB, WS_BTO = 500 * MiB, WS_BTG = 502 * MiB, WS_BTP = 504 * MiB;
constexpr size_t WS_RINV = 505 * MiB, WS_R1 = WS_RINV + 256 * 1024, WS_LBV = WS_R1 + 256 * 1024, WS_DEC = 506 * MiB, WS_SSQ = 509 * MiB, WS_END = 512 * MiB;
constexpr size_t WS_SSQ2 = WS_DEC + 1 * MiB;
constexpr size_t WS_BAR = 511 * MiB + 512 * 1024;
constexpr size_t WS_DST = WS_U;
constexpr size_t WS_MG = WS_U;
constexpr size_t WS_OUT = WS_Q;
constexpr size_t WS_X1B = WS_V;
constexpr size_t WS_PB = WS_BTIN;
constexpr size_t WS_PP = WS_LFH;
static_assert(BUF == 68 * MiB, "buffer size");
static_assert(WS_DEC + (size_t)NCHUNK * 8 * 128 * 4 <= WS_SSQ && WS_SSQ + (size_t)M_TOK * 16 * 4 <= WS_END, "ws map");
constexpr size_t O_Y = 0, O_CONVP = (size_t)M_TOK * DM, O_HP = O_CONVP + 4 * 2 * 1024, O_CONVS = O_HP + (size_t)4 * 8 * 128 * 128, O_HS = O_CONVS + 32 * 2 * 1024;
constexpr size_t O_TOTAL = O_HS + (size_t)32 * 8 * 128 * 128;

struct Args { const float* in[18]; float* out; unsigned char* ws; };

__device__ __forceinline__ void p0_transpose(const float* W, int N, const float* scale, bf16_t* dst, int ldk, int koff, int dstrow0, int k0, int n0, LAS float* scr, int lane, bool amap = false) {
    float wv[32], sv[32];
#pragma unroll
    for (int i = 0; i < 32; ++i) { const int kk = 2 * i + (lane >> 5); wv[i] = __builtin_nontemporal_load(W + (size_t)(k0 + kk) * N + n0 + (lane & 31)); sv[i] = scale ? scale[k0 + kk] : 1.0f; }
#pragma unroll
    for (int i = 0; i < 32; ++i) { const int kk = 2 * i + (lane >> 5); scr[kk * 33 + (lane & 31)] = wv[i] * sv[i]; }
    LDS_WAIT(); asm volatile("" ::: "memory");
    const int c = lane & 7;
#pragma unroll
    for (int j = 0; j < 4; ++j) { const int n = (lane >> 3) + 8 * j; const LAS float* s = scr + (8 * c) * 33 + n;
        u32x4 o; o.x = cvt_pk_bf16(s[0 * 33], s[1 * 33]); o.y = cvt_pk_bf16(s[2 * 33], s[3 * 33]); o.z = cvt_pk_bf16(s[4 * 33], s[5 * 33]); o.w = cvt_pk_bf16(s[6 * 33], s[7 * 33]);
        const int nr = amap ? (32 * (n >> 4) + 8 * ((n >> 2) & 3) + (n & 3)) : n;
        *(u32x4*)(dst + (size_t)(dstrow0 + nr) * ldk + koff + k0 + 8 * c) = o; }
    LDS_WAIT(); asm volatile("" ::: "memory");
}

#define VT_GRP(v_, g_) ((((g_) ^ (((v_) >> 3) & 7)) << 3))
constexpr int NSC = 4;
constexpr int NSU = (NCHUNK_P / NSC) * 8;
constexpr int NSMP = (NCHUNK - NCHUNK_P) * 8;
__device__ __forceinline__ void step_map(int j, int nps, int bid, int G, int& un, int& su, bool& first, bool& last) {
    if (j < nps) { const int i = j / NSC, c = j % NSC; su = bid + G * i; un = (((su >> 3) * NSC + c) << 3) + (su & 7); first = (c == 0); last = (c == NSC - 1); }
    else { su = -1; un = NCHUNK_P * 8 + bid + G * (j - nps); first = true; last = true; }
}
__device__ __forceinline__ void p2b_scan(const LAS unsigned short* LF, LAS unsigned short* kd, LAS float* decs, float* decg, bool first, bool last, float& dprod, int tid) {
    const int k = tid & 127, tq = tid >> 7;
    float lfv[16];
#pragma unroll
    for (int j = 0; j < 16; ++j) lfv[j] = h2f(LF[(tq * 16 + j) * 136 + k]);
    float r = 0.f;
    for (int q2 = tq + 1; q2 < 4; ++q2) {
#pragma unroll
        for (int j = 0; j < 16; ++j) r += h2f(LF[(q2 * 16 + j) * 136 + k]);
    }
    float kv[16];
    float er = __expf(r);
#pragma unroll
    for (int j = 15; j >= 0; --j) { const float fj = __expf(lfv[j]); kv[j] = (1.0f - fj) * er; er *= fj; r += lfv[j]; }
    u32x4 w0, w1;
    w0.x = cvt_pk_bf16(kv[0], kv[1]); w0.y = cvt_pk_bf16(kv[2], kv[3]); w0.z = cvt_pk_bf16(kv[4], kv[5]); w0.w = cvt_pk_bf16(kv[6], kv[7]);
    w1.x = cvt_pk_bf16(kv[8], kv[9]); w1.y = cvt_pk_bf16(kv[10], kv[11]); w1.z = cvt_pk_bf16(kv[12], kv[13]); w1.w = cvt_pk_bf16(kv[14], kv[15]);
    *(LAS u32x4*)(kd + k * 72 + tq * 16) = w0; *(LAS u32x4*)(kd + k * 72 + tq * 16 + 8) = w1;
    if (tq == 0) { const float d = __expf(r); decs[k] = d; dprod = first ? d : dprod * d; if (last && decg) decg[k] = dprod; }
}
__device__ __forceinline__ void p2b_mfma(const LAS unsigned short* kd, const LAS unsigned short* vT, const LAS float* decs, int un, int su, bool first, bool last,
                                         f32x16& acc0, f32x16& acc1, bf16_t* DST, const float* st_hgrn, float* out_hs, int wave, int lane) {
    const int cidx = un >> 3, h = un & 7;
    const int kt = wave >> 1, vt0 = (wave & 1) * 2, r = lane & 31, hh = lane >> 5;
    const int v0 = vt0 * 32 + r, v1 = v0 + 32;
    if (first) {
#pragma unroll
        for (int i = 0; i < 16; ++i) { acc0[i] = 0.f; acc1[i] = 0.f; }
    } else {
#pragma unroll
        for (int i = 0; i < 16; ++i) { const float d = decs[kt * 32 + (i & 3) + 8 * (i >> 2) + 4 * hh]; acc0[i] *= d; acc1[i] *= d; }
    }
#pragma unroll
    for (int ks = 0; ks < 4; ++ks) {
        const bf16x8 af = *(const LAS bf16x8*)(kd + (kt * 32 + r) * 72 + 16 * ks + 8 * hh);
        const bf16x8 b0 = *(const LAS bf16x8*)(vT + v0 * 72 + VT_GRP(v0, 2 * ks + hh));
        const bf16x8 b1 = *(const LAS bf16x8*)(vT + v1 * 72 + VT_GRP(v1, 2 * ks + hh));
        acc0 = __builtin_amdgcn_mfma_f32_32x32x16_bf16(af, b0, acc0, 0, 0, 0);
        acc1 = __builtin_amdgcn_mfma_f32_32x32x16_bf16(af, b1, acc1, 0, 0, 0);
    }
    if (!last) return;
    if (su >= 0) {
        bf16_t* dp = DST + (size_t)su * 16384 + (kt * 4 + vt0) * 1024 + lane * 4;
#pragma unroll
        for (int q = 0; q < 4; ++q) {
            u32x2 w0, w1; w0.x = cvt_pk_bf16(acc0[4 * q], acc0[4 * q + 1]); w0.y = cvt_pk_bf16(acc0[4 * q + 2], acc0[4 * q + 3]);
            w1.x = cvt_pk_bf16(acc1[4 * q], acc1[4 * q + 1]); w1.y = cvt_pk_bf16(acc1[4 * q + 2], acc1[4 * q + 3]);
            *(u32x2*)(dp + q * 256) = w0; *(u32x2*)(dp + 1024 + q * 256) = w1; }
    } else {
        const size_t sbase = ((size_t)(cidx - NCHUNK_P) * 8 + h) * 16384;
        const float* s0 = st_hgrn + sbase; float* so = out_hs + sbase;
        float p0[16], p1[16];
#pragma unroll
        for (int i = 0; i < 16; ++i) { const int k = kt * 32 + (i & 3) + 8 * (i >> 2) + 4 * hh; p0[i] = s0[k * 128 + v0]; p1[i] = s0[k * 128 + v1]; }
#pragma unroll
        for (int i = 0; i < 16; ++i) { const int k = kt * 32 + (i & 3) + 8 * (i >> 2) + 4 * hh; const float d = decs[k];
            so[k * 128 + v0] = d * p0[i] + acc0[i]; so[k * 128 + v1] = d * p1[i] + acc1[i]; }
    }
}

__device__ __forceinline__ f32x16 mini_gemm(LAS unsigned char* lds, const bf16_t* A, int lda, const bf16_t* Bt, int ldb, int K, int tid, int wave, int lane, f32x16 acc) {
    LAS unsigned short* As0 = (LAS unsigned short*)lds;
    LAS unsigned short* Bs0 = (LAS unsigned short*)(lds + 2 * 9216);
    const int lr = tid >> 3, lp = (tid & 7) * 8;
    const bf16_t* ap = A + (size_t)lr * lda + lp;
    const bf16_t* bp0 = Bt + (size_t)lr * ldb + lp; const bf16_t* bp1 = Bt + (size_t)(lr + 64) * ldb + lp;
    const int nk = K / 64;
    u32x4 ra[4], rb0[4], rb1[4];
#pragma unroll
    for (int s = 0; s < 4; ++s) { ra[s] = *(const u32x4*)(ap + 64 * s); rb0[s] = *(const u32x4*)(bp0 + 64 * s); rb1[s] = *(const u32x4*)(bp1 + 64 * s); }
    *(LAS u32x4*)(As0 + lr * 72 + lp) = ra[0]; *(LAS u32x4*)(Bs0 + lr * 72 + lp) = rb0[0]; *(LAS u32x4*)(Bs0 + (lr + 64) * 72 + lp) = rb1[0];
    __syncthreads();
    const int wr2 = wave >> 2, wc4 = wave & 3, r = lane & 31, hh = lane >> 5;
    for (int kt0 = 0; kt0 < nk; kt0 += 4) {
#pragma unroll
        for (int u = 0; u < 4; ++u) {
            const int kt = kt0 + u;
            if (kt + 4 < nk) { const int ko = (kt + 4) * 64; ra[u] = *(const u32x4*)(ap + ko); rb0[u] = *(const u32x4*)(bp0 + ko); rb1[u] = *(const u32x4*)(bp1 + ko); }
            const LAS unsigned short* As = As0 + (u & 1) * (64 * 72); const LAS unsigned short* Bs = Bs0 + (u & 1) * (128 * 72);
#pragma unroll
            for (int ks = 0; ks < 4; ++ks) {
                const bf16x8 af = *(const LAS bf16x8*)(As + (wr2 * 32 + r) * 72 + 16 * ks + 8 * hh);
                const bf16x8 bfr = *(const LAS bf16x8*)(Bs + (wc4 * 32 + r) * 72 + 16 * ks + 8 * hh);
                acc = __builtin_amdgcn_mfma_f32_32x32x16_bf16(af, bfr, acc, 0, 0, 0);
            }
            if (kt + 1 < nk) {
                LAS unsigned short* An = As0 + ((u + 1) & 1) * (64 * 72); LAS unsigned short* Bn = Bs0 + ((u + 1) & 1) * (128 * 72);
                *(LAS u32x4*)(An + lr * 72 + lp) = ra[(u + 1) & 3]; *(LAS u32x4*)(Bn + lr * 72 + lp) = rb0[(u + 1) & 3]; *(LAS u32x4*)(Bn + (lr + 64) * 72 + lp) = rb1[(u + 1) & 3];
            }
            __syncthreads();
        }
    }
    return acc;
}

#define XB_TMO      128
#define XB_XCNT(j)  (256  + 64 * (j))
#define XB_XSUB(j)  (1280 + 64 * (j))
#define XB_XGEN(j)  (2304 + 64 * (j))
#define XB_TOP      3328
#define XB_TOPGEN   3392
#define XCD_BAR_WORDS 3456
#define XB_SPIN_CAP (1u << 18)
__device__ __forceinline__ unsigned xb_ld(unsigned* p)              { return __hip_atomic_load(p, __ATOMIC_RELAXED, __HIP_MEMORY_SCOPE_AGENT); }
__device__ __forceinline__ unsigned xb_add(unsigned* p, unsigned v) { return __hip_atomic_fetch_add(p, v, __ATOMIC_RELAXED, __HIP_MEMORY_SCOPE_AGENT); }
__device__ __forceinline__ unsigned xb_xcc_id() { return (unsigned)__builtin_amdgcn_s_getreg((3 << 11) | 20) & 0xFu; }
#define XB_SPIN(cond, bar) do { unsigned _sp = 0; while (cond) { __builtin_amdgcn_s_sleep(1); \
    if ((++_sp & 255u) == 0u) { if (xb_ld(&(bar)[XB_TMO])) break; if (_sp > XB_SPIN_CAP) { atomicAdd(&(bar)[XB_TMO], 1u); break; } } } } while (0)
struct XcdBarrier { unsigned* bar; unsigned x; volatile LAS unsigned* st; };
__device__ __forceinline__ XcdBarrier xcd_barrier_post(unsigned* bar, volatile LAS unsigned* st) {
    XcdBarrier b; b.bar = bar; b.x = xb_xcc_id(); b.st = st;
    if (threadIdx.x == 0) (void)xb_add(&bar[XB_XCNT(b.x)], 1u);
    return b;
}
__device__ __forceinline__ void xcd_barrier_complete(unsigned* bar, unsigned x, unsigned& nloc, unsigned& nx) {
    const unsigned G = gridDim.x * gridDim.y * gridDim.z;
    unsigned sum, cnt, mine, sp = 0u;
    for (;;) {
        sum = 0u; cnt = 0u; mine = 0u;
#pragma unroll
        for (unsigned j = 0; j < 16; ++j) { const unsigned c = xb_ld(&bar[XB_XCNT(j)]); sum += c; cnt += (c > 0u) ? 1u : 0u; mine = (j == x) ? c : mine; }
        if (sum == G) break;
        __builtin_amdgcn_s_sleep(1);
        if ((++sp & 255u) == 0u) { if (xb_ld(&bar[XB_TMO])) break; if (sp > XB_SPIN_CAP) { atomicAdd(&bar[XB_TMO], 1u); break; } }
    }
    nloc = mine > 0u ? mine : 1u; nx = cnt > 0u ? cnt : 1u;
}
__device__ __forceinline__ void xcd_barrier(const XcdBarrier& b) {
    asm volatile("s_waitcnt vmcnt(0)" ::: "memory");
    __syncthreads();
    if (threadIdx.x == 0) {
        unsigned* bar = b.bar;
        __builtin_amdgcn_s_waitcnt(0);
        unsigned nloc = b.st[0], nx = b.st[1];
        if (nloc == 0u) { xcd_barrier_complete(bar, b.x, nloc, nx); b.st[0] = nloc; b.st[1] = nx; }
        const unsigned old = xb_add(&bar[XB_XSUB(b.x)], 1u);
        const unsigned gen = old / nloc;
        if (old + 1u == (gen + 1u) * nloc) {
            __builtin_amdgcn_fence(__ATOMIC_RELEASE, "agent");
            asm volatile("s_waitcnt vmcnt(0)" ::: "memory");
            const unsigned og = xb_add(&bar[XB_TOP], 1u);
            const unsigned tg = og / nx;
            if (og + 1u == (tg + 1u) * nx) xb_add(&bar[XB_TOPGEN], 1u);
            else XB_SPIN(xb_ld(&bar[XB_TOPGEN]) == tg, bar);
            __builtin_amdgcn_fence(__ATOMIC_ACQUIRE, "agent");
            xb_add(&bar[XB_XGEN(b.x)], 1u);
            asm volatile("s_waitcnt vmcnt(0)" ::: "memory");
        } else {
            XB_SPIN(xb_ld(&bar[XB_XGEN(b.x)]) == gen, bar);
            __builtin_amdgcn_fence(__ATOMIC_ACQUIRE, "agent");
            asm volatile("s_waitcnt vmcnt(0)" ::: "memory");
        }
    }
    __syncthreads();
}
#define GSYNC() xcd_barrier(bar)

constexpr int LDS_BYTES = 148480;

__global__ void __launch_bounds__(512, 2) fwd_kernel(Args a) {
    extern __shared__ __attribute__((aligned(16))) unsigned char lds_raw[];
    LAS unsigned char* lds = (LAS unsigned char*)lds_raw;
    const int tid = threadIdx.x, lane = tid & 63, wave = __builtin_amdgcn_readfirstlane(tid >> 6);
    const int G = gridDim.x, bid = blockIdx.x;
    const int gw = bid * 8 + wave, NGW = G * 8;
    const int gt = bid * 512 + tid, NGT = G * 512;
    volatile LAS unsigned* stw = (volatile LAS unsigned*)(lds + LDS_BYTES - 16);
    if (tid < 4) stw[tid] = 0u;
    __syncthreads();
    const XcdBarrier bar = xcd_barrier_post((unsigned*)(a.ws + WS_BAR), stw);

    const float* x_p = a.in[0]; const float* x_s = a.in[1]; const float* st_conv = a.in[2]; const float* st_hgrn = a.in[3];
    const float* p_p = a.in[4]; const float* p_s = a.in[5]; const float* w_in = a.in[6]; const float* conv_w = a.in[7]; const float* lb_raw = a.in[8];
    const float* g_pre = a.in[9]; const float* g_onorm = a.in[10]; const float* w_a_out = a.in[11]; const float* w_b_out = a.in[12]; const float* w_o = a.in[13];
    const float* g_post = a.in[14]; const float* g_ple = a.in[15]; const float* w_ple_gate = a.in[16]; const float* w_ple_proj = a.in[17];
    unsigned char* ws = a.ws; float* out = a.out;
    bf16_t* GA = (bf16_t*)(ws + WS_GA); bf16_t* Q = (bf16_t*)(ws + WS_Q); unsigned short* LFH = (unsigned short*)(ws + WS_LFH); bf16_t* V = (bf16_t*)(ws + WS_V);
    bf16_t* SZ = (bf16_t*)(ws + WS_SZ); bf16_t* UF = (bf16_t*)(ws + WS_U + 40 * MiB);    bf16_t* XB = (bf16_t*)(ws + WS_XB);
    bf16_t* BTIN = (bf16_t*)(ws + WS_BTIN); bf16_t* BTAB = (bf16_t*)(ws + WS_BTAB); bf16_t* BTO = (bf16_t*)(ws + WS_BTO); bf16_t* BTG = (bf16_t*)(ws + WS_BTG); bf16_t* BTP = (bf16_t*)(ws + WS_BTP);
    float* RINV = (float*)(ws + WS_RINV); float* R1 = (float*)(ws + WS_R1); float* LBV = (float*)(ws + WS_LBV); float* DEC = (float*)(ws + WS_DEC); float* SSQ = (float*)(ws + WS_SSQ); float* SSQ2 = (float*)(ws + WS_SSQ2);
    bf16_t* DST = (bf16_t*)(ws + WS_DST); bf16_t* MG = (bf16_t*)(ws + WS_MG); bf16_t* OUTB = (bf16_t*)(ws + WS_OUT); bf16_t* X1B = (bf16_t*)(ws + WS_X1B);
    bf16_t* PB = (bf16_t*)(ws + WS_PB); bf16_t* PP = (bf16_t*)(ws + WS_PP);
    bf16_t* SGA = (bf16_t*)(out + O_Y); bf16_t* SGB = (bf16_t*)((unsigned char*)(out + O_Y) + BUF);

    {
        LAS float* scr = (LAS float*)(lds + wave * 16384);
        constexpr int I_IN = 16 * 320, I_SQ = 16 * 32, I_P = 4 * 32;
        constexpr int NITEMS = I_IN + 4 * I_SQ + I_P;
        for (int it = gw; it < NITEMS; it += NGW) {
            int r = it;
            if (r < I_IN) {
                const int kb = r / 320, nb = r % 320, n0 = nb * 32, seg = n0 >> 10, ch = n0 & 1023;
                if (seg < 4) {
                    const int kind = ((seg & 1) << 1) | (seg >> 1);
                    const int drowa = (ch >> 6) * 256 + 128 * (kind >> 1) + 32 * ((ch >> 4) & 3) + 4 * (kind & 1);
                    p0_transpose(w_in, NIN, g_pre, BTIN, DM, 0, drowa, kb * 64, n0, scr, lane, true); continue; }
                const int code = seg;
                const int drow = (((code >> 1) * 8 + (ch >> 7)) * 256) + (code & 1) * 128 + (ch & 127);
                p0_transpose(w_in, NIN, g_pre, BTIN, DM, 0, drow, kb * 64, n0, scr, lane); continue; }
            r -= I_IN;
            if (r < I_SQ) { p0_transpose(w_a_out, DM, nullptr, BTAB, 2048, 0, (r % 32) * 32, (r / 32) * 64, (r % 32) * 32, scr, lane); continue; } r -= I_SQ;
            if (r < I_SQ) { p0_transpose(w_b_out, DM, g_onorm, BTAB, 2048, 1024, (r % 32) * 32, (r / 32) * 64, (r % 32) * 32, scr, lane); continue; } r -= I_SQ;
            if (r < I_SQ) { p0_transpose(w_o, DM, nullptr, BTO, DM, 0, (r % 32) * 32, (r / 32) * 64, (r % 32) * 32, scr, lane); continue; } r -= I_SQ;
            if (r < I_SQ) { p0_transpose(w_ple_gate, DM, g_ple, BTG, DM, 0, (r % 32) * 32, (r / 32) * 64, (r % 32) * 32, scr, lane); continue; } r -= I_SQ;
            p0_transpose(w_ple_proj, DM, nullptr, BTP, DPLE, 0, (r % 32) * 32, (r / 32) * 64, (r % 32) * 32, scr, lane);
        }
        for (int m0 = gw; m0 < M_TOK; m0 += 2 * NGW) {
            const int m1 = m0 + NGW; const bool has1 = m1 < M_TOK; const int m1c = has1 ? m1 : m0;
            const f32x4* xr0 = (const f32x4*)((m0 < MP) ? x_p + (size_t)m0 * DM : x_s + (size_t)(m0 - MP) * DM) + lane;
            const f32x4* xr1 = (const f32x4*)((m1c < MP) ? x_p + (size_t)m1c * DM : x_s + (size_t)(m1c - MP) * DM) + lane;
            f32x4 v0[4], v1[4]; float s0 = 0.f, s1 = 0.f;
#pragma unroll
            for (int j = 0; j < 4; ++j) { v0[j] = __builtin_nontemporal_load(xr0 + 64 * j); v1[j] = __builtin_nontemporal_load(xr1 + 64 * j); }
#pragma unroll
            for (int j = 0; j < 4; ++j) { s0 += (v0[j][0] * v0[j][0] + v0[j][1] * v0[j][1]) + (v0[j][2] * v0[j][2] + v0[j][3] * v0[j][3]);
                                          s1 += (v1[j][0] * v1[j][0] + v1[j][1] * v1[j][1]) + (v1[j][2] * v1[j][2] + v1[j][3] * v1[j][3]); }
            s0 = wave_sum(s0); s1 = wave_sum(s1);
            if (lane == 0) { RINV[m0] = rsqrtf(s0 * (1.0f / DM) + EPS); if (has1) RINV[m1] = rsqrtf(s1 * (1.0f / DM) + EPS); }
            u32x2* o0 = (u32x2*)(XB + (size_t)m0 * DM) + lane; u32x2* o1 = (u32x2*)(XB + (size_t)m1c * DM) + lane;
#pragma unroll
            for (int j = 0; j < 4; ++j) { u32x2 w; w.x = cvt_pk_bf16(v0[j][0], v0[j][1]); w.y = cvt_pk_bf16(v0[j][2], v0[j][3]); o0[64 * j] = w; }
            if (has1) {
#pragma unroll
                for (int j = 0; j < 4; ++j) { u32x2 w; w.x = cvt_pk_bf16(v1[j][0], v1[j][1]); w.y = cvt_pk_bf16(v1[j][2], v1[j][3]); o1[64 * j] = w; }
            }
        }
        if (bid == 0) for (int j = tid; j < 1024; j += 512) { const float e0 = __expf(lb_raw[j]), e1 = __expf(lb_raw[1024 + j]); LBV[j] = e0 / (e0 + e1); }
    }
    GSYNC();

    {
        pg8::Gemm g{XB, nullptr, BTIN, M_TOK, NIN, DM, DM, DM, 0}; pg8::StaticOrder S; S.init(M_TOK, NIN, G, bid);
        Epi1 E{RINV, LBV, UF, GA, Q, V, SZ, SGA, SGB, LFH, out + O_CONVP, out + O_CONVS, conv_w, lds + 131072};
        pg8::gemm_phase<Epi1, true, true>(lds, g, S, E);
    }
    GSYNC();

    {
        for (int it = gt; it < (M_TOK / 64) * 2 * 128; it += NGT) {
            const int c8 = (it & 127) * 8, t = (it >> 7) & 1, blk = it >> 8; const int row = blk * 64 + t;
            const bool seq0 = (blk >= NCHUNK_P) || ((blk & 127) == 0);
            f32x4 u2a, u2b, u1a, u1b, u0a, u0b;
            unpack8(*(const u32x4*)(UF + ((size_t)blk * 4 + t) * DM + c8), u2a, u2b);
            if (t == 1) unpack8(*(const u32x4*)(UF + ((size_t)blk * 4 + 0) * DM + c8), u1a, u1b);
            else if (!seq0) unpack8(*(const u32x4*)(UF + ((size_t)(blk - 1) * 4 + 3) * DM + c8), u1a, u1b);
            else if (blk >= NCHUNK_P) { const float* hp = st_conv + ((size_t)(blk - NCHUNK_P) * 2 + 1) * DM + c8; u1a = *(const f32x4*)hp; u1b = *(const f32x4*)(hp + 4); }
            else { u1a = (f32x4){0.f, 0.f, 0.f, 0.f}; u1b = u1a; }
            if (!seq0) unpack8(*(const u32x4*)(UF + ((size_t)(blk - 1) * 4 + 2 + t) * DM + c8), u0a, u0b);
            else if (blk >= NCHUNK_P) { const float* hp = st_conv + ((size_t)(blk - NCHUNK_P) * 2 + t) * DM + c8; u0a = *(const f32x4*)hp; u0b = *(const f32x4*)(hp + 4); }
            else { u0a = (f32x4){0.f, 0.f, 0.f, 0.f}; u0b = u0a; }
            const f32x4 w0a = *(const f32x4*)(conv_w + c8), w0b = *(const f32x4*)(conv_w + c8 + 4);
            const f32x4 w1a = *(const f32x4*)(conv_w + DM + c8), w1b = *(const f32x4*)(conv_w + DM + c8 + 4);
            const f32x4 w2a = *(const f32x4*)(conv_w + 2 * DM + c8), w2b = *(const f32x4*)(conv_w + 2 * DM + c8 + 4);
            f32x4 ga, gb; u32x4* gp = (u32x4*)(GA + (size_t)row * DM + c8); unpack8(*gp, ga, gb);
            *gp = pack8(ga * (w0a * u0a + w1a * u1a + w2a * u2a), gb * (w0b * u0b + w1b * u1b + w2b * u2b));
        }
        for (int it = gt; it < M_TOK * 32; it += NGT) {
            const int row = it >> 5, c8 = (it & 31) * 8;
            const float* pr = (row < MP) ? p_p + (size_t)row * DPLE + c8 : p_s + (size_t)(row - MP) * DPLE + c8;
            *(u32x4*)(PB + (size_t)row * DPLE + c8) = pack8(*(const f32x4*)pr, *(const f32x4*)(pr + 4));
        }
    }

#define LOAD_TILE2(dst, X, un_) do { const int c_ = (un_) >> 3, h_ = (un_) & 7; _Pragma("unroll") for (int i_ = 0; i_ < 2; ++i_) { const int p_ = tid + 512 * i_; \
        dst[i_] = *(const u32x4*)((X) + ((size_t)c_ * 64 + (p_ >> 4)) * DM + h_ * 128 + (p_ & 15) * 8); } } while (0)
#define LOAD_TILE2_NT(dst, X, un_) do { const int c_ = (un_) >> 3, h_ = (un_) & 7; _Pragma("unroll") for (int i_ = 0; i_ < 2; ++i_) { const int p_ = tid + 512 * i_; \
        dst[i_] = __builtin_nontemporal_load((const u32x4*)((X) + ((size_t)c_ * 64 + (p_ >> 4)) * DM + h_ * 128 + (p_ & 15) * 8)); } } while (0)
#define SCATTER_VT(vt_, w_, s_, vg_) do { LAS unsigned short* d_ = (vt_) + ((vg_) * 8) * 72 + VT_GRP((vg_) * 8, (s_) >> 3) + ((s_) & 7); \
        d_[0 * 72] = (unsigned short)((w_).x & 0xffff); d_[1 * 72] = (unsigned short)((w_).x >> 16); d_[2 * 72] = (unsigned short)((w_).y & 0xffff); d_[3 * 72] = (unsigned short)((w_).y >> 16); \
        d_[4 * 72] = (unsigned short)((w_).z & 0xffff); d_[5 * 72] = (unsigned short)((w_).z >> 16); d_[6 * 72] = (unsigned short)((w_).w & 0xffff); d_[7 * 72] = (unsigned short)((w_).w >> 16); } while (0)
    {
        LAS unsigned short* LFb = (LAS unsigned short*)lds;
        LAS unsigned short* kdb = (LAS unsigned short*)(lds + 34816);
        LAS unsigned short* vTb = (LAS unsigned short*)(lds + 71680);
        LAS float* decb = (LAS float*)(lds + 126976);
        const int nsu = (bid < NSU) ? (NSU - bid + G - 1) / G : 0, nps = NSC * nsu;
        const int nst = nps + ((bid < NSMP) ? (NSMP - bid + G - 1) / G : 0);
        u32x4 plf[2], pv[2];
        f32x16 acc0, acc1; float dprod = 1.f;
#pragma unroll
        for (int i = 0; i < 16; ++i) { acc0[i] = 0.f; acc1[i] = 0.f; }
#define P2B_LOAD(j_) do { int un_, su_; bool f_, l_; step_map((j_), nps, bid, G, un_, su_, f_, l_); LOAD_TILE2(plf, LFH, un_); LOAD_TILE2(pv, V, un_); } while (0)
#define P2B_STAGE(j_) do { LAS unsigned short* LF_ = LFb + ((j_) & 1) * (64 * 136); LAS unsigned short* vT_ = vTb + ((j_) % 3) * (128 * 72); \
        _Pragma("unroll") for (int i = 0; i < 2; ++i) { const int p = tid + 512 * i, t = p >> 4, g8 = p & 15; *(LAS u32x4*)(LF_ + t * 136 + g8 * 8) = plf[i]; SCATTER_VT(vT_, pv[i], t, g8); } } while (0)
#define P2B_SCAN(j_) do { int un_, su_; bool f_, l_; step_map((j_), nps, bid, G, un_, su_, f_, l_); \
        p2b_scan(LFb + ((j_) & 1) * (64 * 136), kdb + ((j_) & 1) * (128 * 72), decb + ((j_) & 1) * 128, su_ >= 0 ? DEC + (size_t)su_ * 128 : nullptr, f_, l_, dprod, tid); } while (0)
        if (nst > 0) {
            P2B_LOAD(0); P2B_STAGE(0);
            if (nst > 1) P2B_LOAD(1);
            __syncthreads();
            P2B_SCAN(0);
            if (nst > 1) P2B_STAGE(1);
            if (nst > 2) P2B_LOAD(2);
            __syncthreads();
            for (int j = 0; j < nst; ++j) {
                if (j + 2 < nst) P2B_STAGE(j + 2);
                if (j + 3 < nst) P2B_LOAD(j + 3);
                { int un, su; bool first, last; step_map(j, nps, bid, G, un, su, first, last);
                  p2b_mfma(kdb + (j & 1) * (128 * 72), vTb + (j % 3) * (128 * 72), decb + (j & 1) * 128, un, su, first, last, acc0, acc1, DST, st_hgrn, out + O_HS, wave, lane); }
                if (j + 1 < nst) P2B_SCAN(j + 1);
                __syncthreads();
            }
        }
    }
    GSYNC();

    {
        constexpr int NSQ = NCHUNK_P / NSC / 4;
        for (int it = gt; it < 32 * 4096; it += NGT) {
            const int bh = it >> 12, g4 = it & 4095, b = bh >> 3, h = bh & 7;
            const int v = ((g4 >> 8) & 3) * 32 + (g4 & 31), k0 = (g4 >> 10) * 32 + 8 * ((g4 >> 6) & 3) + 4 * ((g4 >> 5) & 1);
            float S0 = 0.f, S1 = 0.f, S2 = 0.f, S3 = 0.f;
            for (int c0 = 0; c0 < NSQ; c0 += 8) {
                u32x2 ds[8]; f32x4 dc[8];
#pragma unroll
                for (int j = 0; j < 8; ++j) { const size_t su = ((size_t)(b * NSQ + c0 + j)) * 8 + h; ds[j] = *(const u32x2*)(DST + su * 16384 + g4 * 4); dc[j] = *(const f32x4*)(DEC + su * 128 + k0); }
#pragma unroll
                for (int j = 0; j < 8; ++j) { const size_t su = ((size_t)(b * NSQ + c0 + j)) * 8 + h;
                    u32x2 w; w.x = cvt_pk_bf16(S0, S1); w.y = cvt_pk_bf16(S2, S3);
                    *(u32x2*)(DST + su * 16384 + g4 * 4) = w;
                    S0 = dc[j][0] * S0 + bflo(ds[j].x); S1 = dc[j][1] * S1 + bfhi(ds[j].x); S2 = dc[j][2] * S2 + bflo(ds[j].y); S3 = dc[j][3] * S3 + bfhi(ds[j].y); }
            }
            float* so = out + O_HP + (size_t)bh * 16384;
            so[(k0 + 0) * 128 + v] = S0; so[(k0 + 1) * 128 + v] = S1; so[(k0 + 2) * 128 + v] = S2; so[(k0 + 3) * 128 + v] = S3;
        }
    }
    GSYNC();

    {
        LAS unsigned short* LF = (LAS unsigned short*)lds;
        LAS unsigned short* QS = (LAS unsigned short*)(lds + 17408);
        LAS unsigned short* vT = (LAS unsigned short*)(lds + 34816);
        LAS unsigned short* qe = (LAS unsigned short*)(lds + 53248);
        LAS unsigned short* ke = (LAS unsigned short*)(lds + 70656);
        LAS unsigned short* qb = (LAS unsigned short*)(lds + 88064);
        LAS unsigned short* kd = (LAS unsigned short*)(lds + 105472);
        LAS unsigned short* ost = (LAS unsigned short*)(lds + 123904);
        LAS float* qsum = (LAS float*)(lds + 141312);
        LAS float* decs = (LAS float*)(lds + 143360);
        const int nsu = (bid < NSU) ? (NSU - bid + G - 1) / G : 0, nps = NSC * nsu;
        const int nst = nps + ((bid < NSMP) ? (NSMP - bid + G - 1) / G : 0);
        const int tb = wave & 1, vb = wave >> 1, r = lane & 31, hh = lane >> 5;
        u32x4 plf[2], pq[2], pv[2];
        u32x4 sfr[8];
#pragma unroll
        for (int i = 0; i < 8; ++i) sfr[i] = (u32x4){0u, 0u, 0u, 0u};
        if (nst > 0) { int un_, su_; bool f_, l_; step_map(0, nps, bid, G, un_, su_, f_, l_); LOAD_TILE2_NT(plf, LFH, un_); LOAD_TILE2_NT(pq, Q, un_); LOAD_TILE2_NT(pv, V, un_); }
        for (int j = 0; j < nst; ++j) {
            int un, su; bool first, last; step_map(j, nps, bid, G, un, su, first, last);
            const int cidx = un >> 3, h = un & 7; const size_t row0 = (size_t)cidx * 64;
#pragma unroll
            for (int i = 0; i < 2; ++i) { const int p = tid + 512 * i, t = p >> 4, g8 = p & 15;
                *(LAS u32x4*)(LF + t * 136 + g8 * 8) = plf[i]; *(LAS u32x4*)(QS + t * 136 + g8 * 8) = pq[i]; SCATTER_VT(vT, pv[i], t, g8); }
            if (first) {
                if (su >= 0) {
                    const bf16_t* sp = DST + (size_t)su * 16384 + vb * 1024 + launder(lane) * 4;
#pragma unroll
                    for (int kt = 0; kt < 4; ++kt)
#pragma unroll
                        for (int s2 = 0; s2 < 2; ++s2) { const u32x2 lo = *(const u32x2*)(sp + kt * 4096 + (2 * s2) * 256), hi = *(const u32x2*)(sp + kt * 4096 + (2 * s2 + 1) * 256);
                            sfr[kt * 2 + s2] = (u32x4){lo.x, lo.y, hi.x, hi.y}; }
                } else {
                    const float* s0 = st_hgrn + ((size_t)(cidx - NCHUNK_P) * 8 + h) * 16384 + vb * 32 + r;
#pragma unroll
                    for (int f8 = 0; f8 < 8; ++f8) { float sv[8];
#pragma unroll
                        for (int e = 0; e < 8; ++e) sv[e] = s0[(size_t)(16 * f8 + 8 * (e >> 2) + 4 * hh + (e & 3)) * 128];
                        sfr[f8] = (u32x4){cvt_pk_bf16(sv[0], sv[1]), cvt_pk_bf16(sv[2], sv[3]), cvt_pk_bf16(sv[4], sv[5]), cvt_pk_bf16(sv[6], sv[7])}; }
                }
            }
            __syncthreads();
            if (j + 1 < nst) { int un_, su_; bool f_, l_; step_map(j + 1, nps, bid, G, un_, su_, f_, l_); LOAD_TILE2_NT(plf, LFH, un_); LOAD_TILE2_NT(pq, Q, un_); LOAD_TILE2_NT(pv, V, un_); }
            {
                const int k = tid & 127, tq = tid >> 7;
                float lfv[16]; float ssum = 0.f;
#pragma unroll
                for (int jj = 0; jj < 16; ++jj) { lfv[jj] = h2f(LF[(tq * 16 + jj) * 136 + k]); ssum += lfv[jj]; }
                qsum[tq * 128 + k] = ssum;
                __syncthreads();
                const float s0q = qsum[k], s1q = qsum[128 + k], s2q = qsum[256 + k], s3q = qsum[384 + k];
                const float ref = s0q + s1q, btot = (s0q + s1q) + (s2q + s3q);
                float b = (tq > 0 ? s0q : 0.f) + (tq > 1 ? s1q : 0.f) + (tq > 2 ? s2q : 0.f);
                float kv[16];
                const float eref = __expf(ref), etot = __expf(btot - ref); float e1 = __expf(b - ref);
#pragma unroll
                for (int jj = 0; jj < 16; ++jj) { const int t = tq * 16 + jj;
                    const float q = silu_f(bf2f(QS[t * 136 + k])) * QK_SCALE;
                    b += lfv[jj];
                    const float fj = __expf(lfv[jj]); const float kk = 1.0f - fj;
                    e1 *= fj;
                    const float qev = q * e1, kev = kk * __builtin_amdgcn_rcpf(e1);
                    kv[jj] = kev * etot;
                    qe[t * 136 + k] = f2bf(qev); ke[t * 136 + k] = f2bf(kev); qb[t * 136 + k] = f2bf(qev * eref); }
                u32x4 w0, w1;
                w0.x = cvt_pk_bf16(kv[0], kv[1]); w0.y = cvt_pk_bf16(kv[2], kv[3]); w0.z = cvt_pk_bf16(kv[4], kv[5]); w0.w = cvt_pk_bf16(kv[6], kv[7]);
                w1.x = cvt_pk_bf16(kv[8], kv[9]); w1.y = cvt_pk_bf16(kv[10], kv[11]); w1.z = cvt_pk_bf16(kv[12], kv[13]); w1.w = cvt_pk_bf16(kv[14], kv[15]);
                *(LAS u32x4*)(kd + k * 72 + tq * 16) = w0; *(LAS u32x4*)(kd + k * 72 + tq * 16 + 8) = w1;
                if (tq == 0) decs[k] = __expf(btot);
            }
            __syncthreads();
            f32x16 oacc;
#pragma unroll
            for (int i = 0; i < 16; ++i) oacc[i] = 0.f;
            {
                const LAS unsigned short* qrow = qb + (tb * 32 + r) * 136 + 4 * hh;
#pragma unroll
                for (int kt = 0; kt < 4; ++kt)
#pragma unroll
                    for (int s2 = 0; s2 < 2; ++s2) {
                        const bf16x8 bfr = __builtin_bit_cast(bf16x8, sfr[kt * 2 + s2]);
                        const s16x4 lo = *(const LAS s16x4*)(qrow + 32 * kt + 16 * s2), hi = *(const LAS s16x4*)(qrow + 32 * kt + 16 * s2 + 8);
                        const bf16x8 af = __builtin_shufflevector(lo, hi, 0, 1, 2, 3, 4, 5, 6, 7);
                        oacc = __builtin_amdgcn_mfma_f32_32x32x16_bf16(af, bfr, oacc, 0, 0, 0);
                        if (s2 == 1) __builtin_amdgcn_sched_barrier(0);
                    }
            }
            __builtin_amdgcn_sched_barrier(0);
            const int vrow = vb * 32 + r;
            for (int sb = 0; sb <= tb; ++sb) {
                f32x16 att;
#pragma unroll
                for (int i = 0; i < 16; ++i) att[i] = 0.f;
#pragma unroll
                for (int ks = 0; ks < 8; ++ks) {
                    const bf16x8 af = *(const LAS bf16x8*)(ke + (sb * 32 + r) * 136 + 16 * ks + 8 * hh);
                    const bf16x8 bfr = *(const LAS bf16x8*)(qe + (tb * 32 + r) * 136 + 16 * ks + 8 * hh);
                    att = __builtin_amdgcn_mfma_f32_32x32x16_bf16(af, bfr, att, 0, 0, 0);
                    if (ks & 1) __builtin_amdgcn_sched_barrier(0);
                }
                if (sb == tb) {
#pragma unroll
                    for (int i = 0; i < 16; ++i) { const int sl = (i & 3) + 8 * (i >> 2) + 4 * hh; if (sl > r) att[i] = 0.f; }
                }
#pragma unroll
                for (int s2 = 0; s2 < 2; ++s2) {
                    u32x4 w; w.x = cvt_pk_bf16(att[8 * s2 + 0], att[8 * s2 + 1]); w.y = cvt_pk_bf16(att[8 * s2 + 2], att[8 * s2 + 3]);
                    w.z = cvt_pk_bf16(att[8 * s2 + 4], att[8 * s2 + 5]); w.w = cvt_pk_bf16(att[8 * s2 + 6], att[8 * s2 + 7]);
                    const bf16x8 af = __builtin_bit_cast(bf16x8, w);
                    const LAS unsigned short* vp = vT + vrow * 72 + 4 * hh;
                    const s16x4 lo = *(const LAS s16x4*)(vp + VT_GRP(vrow, sb * 4 + 2 * s2)), hi = *(const LAS s16x4*)(vp + VT_GRP(vrow, sb * 4 + 2 * s2 + 1));
                    const bf16x8 bfr = __builtin_shufflevector(lo, hi, 0, 1, 2, 3, 4, 5, 6, 7);
                    oacc = __builtin_amdgcn_mfma_f32_32x32x16_bf16(af, bfr, oacc, 0, 0, 0);
                }
            }
#pragma unroll
            for (int i = 0; i < 16; ++i) ost[(tb * 32 + (i & 3) + 8 * (i >> 2) + 4 * hh) * 136 + vb * 32 + r] = f2bf(oacc[i]);
            __builtin_amdgcn_sched_barrier(0);
            if (!last) {
#pragma unroll
                for (int kt = 0; kt < 4; ++kt) {
                    f32x16 d;
#pragma unroll
                    for (int s2 = 0; s2 < 2; ++s2) { const u32x4 w = sfr[kt * 2 + s2];
                        d[8 * s2 + 0] = bflo(w.x); d[8 * s2 + 1] = bfhi(w.x); d[8 * s2 + 2] = bflo(w.y); d[8 * s2 + 3] = bfhi(w.y);
                        d[8 * s2 + 4] = bflo(w.z); d[8 * s2 + 5] = bfhi(w.z); d[8 * s2 + 6] = bflo(w.w); d[8 * s2 + 7] = bfhi(w.w); }
#pragma unroll
                    for (int i = 0; i < 16; ++i) d[i] *= decs[kt * 32 + (i & 3) + 8 * (i >> 2) + 4 * hh];
#pragma unroll
                    for (int ks = 0; ks < 4; ++ks) {
                        const bf16x8 af = *(const LAS bf16x8*)(kd + (kt * 32 + r) * 72 + 16 * ks + 8 * hh);
                        const bf16x8 bfr = *(const LAS bf16x8*)(vT + vrow * 72 + VT_GRP(vrow, 2 * ks + hh));
                        d = __builtin_amdgcn_mfma_f32_32x32x16_bf16(af, bfr, d, 0, 0, 0);
                    }
#pragma unroll
                    for (int s2 = 0; s2 < 2; ++s2)
                        sfr[kt * 2 + s2] = (u32x4){cvt_pk_bf16(d[8 * s2 + 0], d[8 * s2 + 1]), cvt_pk_bf16(d[8 * s2 + 2], d[8 * s2 + 3]), cvt_pk_bf16(d[8 * s2 + 4], d[8 * s2 + 5]), cvt_pk_bf16(d[8 * s2 + 6], d[8 * s2 + 7])};
                    __builtin_amdgcn_sched_barrier(0);
                }
            }
            u32x4 psz[2];
            LOAD_TILE2_NT(psz, SZ, un);
            __syncthreads();
#pragma unroll
            for (int i = 0; i < 2; ++i) { const int p = tid + 512 * i, t = p >> 4, vg = p & 15;
                f32x4 o0, o1, z0, z1; unpack8(*(const LAS u32x4*)(ost + t * 136 + vg * 8), o0, o1);
                float ss = (o0[0] * o0[0] + o0[1] * o0[1]) + (o0[2] * o0[2] + o0[3] * o0[3]) + (o1[0] * o1[0] + o1[1] * o1[1]) + (o1[2] * o1[2] + o1[3] * o1[3]);
                ss += __shfl_xor(ss, 1); ss += __shfl_xor(ss, 2); ss += __shfl_xor(ss, 4); ss += __shfl_xor(ss, 8);
                const float rs = rsqrtf(ss * (1.0f / 128.0f) + EPS);
                unpack8(psz[i], z0, z1);
#pragma unroll
                for (int e = 0; e < 4; ++e) { z0[e] = silu_f(z0[e]); z1[e] = silu_f(z1[e]); }
                *(u32x4*)(SZ + (row0 + t) * DM + h * 128 + vg * 8) = pack8(o0 * rs * z0, o1 * rs * z1);
                __builtin_amdgcn_sched_barrier(0); }
        }
        __syncthreads();
    }
    GSYNC();

    {
        { pg8::Gemm g{GA, SZ, BTAB, MP, DM, 2048, DM, 2048, 16}; pg8::StaticOrder S; S.init(MP, DM, G, bid);
          EpiMerge E{SGA, SGB, MG};
          pg8::gemm_phase<EpiMerge, true, true>(lds, g, S, E); }
        { pg8::Gemm gp{PB, nullptr, BTP, MP, DM, DPLE, DPLE, DPLE, 0}; pg8::StaticOrder S2; S2.init(MP, DM, G, bid);
          EpiPP E2{PP}; pg8::gemm_phase<EpiPP, true, true>(lds, gp, S2, E2); }
        for (int tile = bid; tile < 256; tile += G) {
            const int tr = tile >> 3, tc = tile & 7, rbase = MP + tr * 64, cbase = tc * 128;
            const int wr2 = wave >> 2, wc4 = wave & 3, r = lane & 31, hh = lane >> 5;
            const int col = cbase + wc4 * 32 + r;
            {
                f32x16 accP;
#pragma unroll
                for (int i = 0; i < 16; ++i) accP[i] = 0.f;
                accP = mini_gemm(lds, PB + (size_t)rbase * DPLE, DPLE, BTP + (size_t)cbase * DPLE, DPLE, DPLE, tid, wave, lane, accP);
#pragma unroll
                for (int i = 0; i < 16; ++i) { const int row = rbase + wr2 * 32 + (i & 3) + 8 * (i >> 2) + 4 * hh; PP[(size_t)row * DM + col] = f2bf(accP[i]); }
            }
            f32x16 accA, accB;
#pragma unroll
            for (int i = 0; i < 16; ++i) { accA[i] = 0.f; accB[i] = 0.f; }
            accA = mini_gemm(lds, GA + (size_t)rbase * DM, DM, BTAB + (size_t)cbase * 2048, 2048, DM, tid, wave, lane, accA);
            accB = mini_gemm(lds, SZ + (size_t)rbase * DM, DM, BTAB + (size_t)cbase * 2048 + 1024, 2048, DM, tid, wave, lane, accB);
            float ga[16], gb[16];
#pragma unroll
            for (int i = 0; i < 16; ++i) { const int row = rbase + wr2 * 32 + (i & 3) + 8 * (i >> 2) + 4 * hh; const size_t off = (size_t)row * DM + col;
                ga[i] = bf2f(SGA[off]); gb[i] = bf2f(SGB[off]); }
#pragma unroll
            for (int i = 0; i < 16; ++i) { const int row = rbase + wr2 * 32 + (i & 3) + 8 * (i >> 2) + 4 * hh; const size_t off = (size_t)row * DM + col;
                MG[off] = f2bf(ga[i] * accA[i] + gb[i] * accB[i]); }
        }
    }
    GSYNC();

    {
        { pg8::Gemm g{MG, nullptr, BTO, MP, DM, DM, DM, DM, 0}; pg8::StaticOrder S; S.init(MP, DM, G, bid);
          EpiO E{OUTB, SSQ};
          pg8::gemm_phase<EpiO, true, true>(lds, g, S, E); }
        for (int tile = bid; tile < 256; tile += G) {
            const int tr = tile >> 3, tc = tile & 7, rbase = MP + tr * 64, cbase = tc * 128;
            const int wr2 = wave >> 2, wc4 = wave & 3, r = lane & 31, hh = lane >> 5;
            const int col = cbase + wc4 * 32 + r;
            f32x16 acc;
#pragma unroll
            for (int i = 0; i < 16; ++i) acc[i] = 0.f;
            acc = mini_gemm(lds, MG + (size_t)rbase * DM, DM, BTO + (size_t)cbase * DM, DM, DM, tid, wave, lane, acc);
#pragma unroll
            for (int i = 0; i < 16; ++i) { const int row = rbase + wr2 * 32 + (i & 3) + 8 * (i >> 2) + 4 * hh;
                OUTB[(size_t)row * DM + col] = f2bf(acc[i]);
                float s = acc[i] * acc[i];
                s += __shfl_xor(s, 1); s += __shfl_xor(s, 2); s += __shfl_xor(s, 4); s += __shfl_xor(s, 8); s += __shfl_xor(s, 16);
                if (r == 0) SSQ2[(size_t)(row - MP) * 32 + tc * 4 + wc4] = s; }
        }
    }
    GSYNC();

    {
        const f32x4* gr = (const f32x4*)g_post + lane;
        f32x4 gp[4];
#pragma unroll
        for (int j = 0; j < 4; ++j) gp[j] = gr[64 * j];
        for (int m0 = gw; m0 < M_TOK; m0 += 2 * NGW) {
            const int m1 = m0 + NGW; const bool has1 = m1 < M_TOK; const int m1c = has1 ? m1 : m0;
            const f32x4* xr0 = (const f32x4*)((m0 < MP) ? x_p + (size_t)m0 * DM : x_s + (size_t)(m0 - MP) * DM) + lane;
            const f32x4* xr1 = (const f32x4*)((m1c < MP) ? x_p + (size_t)m1c * DM : x_s + (size_t)(m1c - MP) * DM) + lane;
            const u32x2* or0 = (const u32x2*)(OUTB + (size_t)m0 * DM) + lane; const u32x2* or1 = (const u32x2*)(OUTB + (size_t)m1c * DM) + lane;
            float sq0 = (m0 < MP) ? ((lane < 16) ? SSQ[(size_t)m0 * 16 + lane] : 0.f) : ((lane < 32) ? SSQ2[(size_t)(m0 - MP) * 32 + lane] : 0.f);
            float sq1 = (m1c < MP) ? ((lane < 16) ? SSQ[(size_t)m1c * 16 + lane] : 0.f) : ((lane < 32) ? SSQ2[(size_t)(m1c - MP) * 32 + lane] : 0.f);
            f32x4 x0[4], x1[4]; u32x2 w0[4], w1[4];
#pragma unroll
            for (int j = 0; j < 4; ++j) { w0[j] = or0[64 * j]; w1[j] = or1[64 * j]; }
            if (m0 < MP) { const u32x2* xq = (const u32x2*)(XB + (size_t)m0 * DM) + lane;
#pragma unroll
                for (int j = 0; j < 4; ++j) { const u32x2 t = xq[64 * j]; x0[j] = (f32x4){bflo(t.x), bfhi(t.x), bflo(t.y), bfhi(t.y)}; } }
            else {
#pragma unroll
                for (int j = 0; j < 4; ++j) x0[j] = xr0[64 * j]; }
            if (m1c < MP) { const u32x2* xq = (const u32x2*)(XB + (size_t)m1c * DM) + lane;
#pragma unroll
                for (int j = 0; j < 4; ++j) { const u32x2 t = xq[64 * j]; x1[j] = (f32x4){bflo(t.x), bfhi(t.x), bflo(t.y), bfhi(t.y)}; } }
            else {
#pragma unroll
                for (int j = 0; j < 4; ++j) x1[j] = xr1[64 * j]; }
            sq0 = wave_sum(sq0); sq1 = wave_sum(sq1);
            const float rs0 = rsqrtf(sq0 * (1.0f / DM) + EPS), rs1 = rsqrtf(sq1 * (1.0f / DM) + EPS);
            float s0 = 0.f, s1 = 0.f;
#pragma unroll
            for (int j = 0; j < 4; ++j) {
                const f32x4 of0 = (f32x4){bflo(w0[j].x), bfhi(w0[j].x), bflo(w0[j].y), bfhi(w0[j].y)}, of1 = (f32x4){bflo(w1[j].x), bfhi(w1[j].x), bflo(w1[j].y), bfhi(w1[j].y)};
                x0[j] = x0[j] + of0 * rs0 * gp[j]; x1[j] = x1[j] + of1 * rs1 * gp[j];
                s0 += (x0[j][0] * x0[j][0] + x0[j][1] * x0[j][1]) + (x0[j][2] * x0[j][2] + x0[j][3] * x0[j][3]);
                s1 += (x1[j][0] * x1[j][0] + x1[j][1] * x1[j][1]) + (x1[j][2] * x1[j][2] + x1[j][3] * x1[j][3]); }
            s0 = wave_sum(s0); s1 = wave_sum(s1);
            if (lane == 0) { R1[m0] = rsqrtf(s0 * (1.0f / DM) + EPS); RINV[m0] = rs0; if (has1) { R1[m1] = rsqrtf(s1 * (1.0f / DM) + EPS); RINV[m1] = rs1; } }
            f32x4* y0 = (f32x4*)(out + O_Y + (size_t)m0 * DM) + lane; u32x2* b0 = (u32x2*)(X1B + (size_t)m0 * DM) + lane;
#pragma unroll
            for (int j = 0; j < 4; ++j) { if (m0 >= MP) y0[64 * j] = x0[j];
                u32x2 w; w.x = cvt_pk_bf16(x0[j][0], x0[j][1]); w.y = cvt_pk_bf16(x0[j][2], x0[j][3]); b0[64 * j] = w; }
            if (has1) {
                f32x4* y1 = (f32x4*)(out + O_Y + (size_t)m1 * DM) + lane; u32x2* b1 = (u32x2*)(X1B + (size_t)m1 * DM) + lane;
#pragma unroll
                for (int j = 0; j < 4; ++j) { if (m1 >= MP) y1[64 * j] = x1[j];
                    u32x2 w; w.x = cvt_pk_bf16(x1[j][0], x1[j][1]); w.y = cvt_pk_bf16(x1[j][2], x1[j][3]); b1[64 * j] = w; }
            }
        }
    }
    GSYNC();

    {
        pg8::StaticOrder S; S.init(M_TOK, DM, G, bid);
        { pg8::Gemm g{X1B, nullptr, BTG, MP, DM, DM, DM, DM, 0}; pg8::StaticOrder Sp; Sp.init(MP, DM, G, bid); EpiFinal E{R1, RINV  , PP, OUTB, x_p, g_post, out + O_Y}; pg8::gemm_phase<EpiFinal, true, true>(lds, g, Sp, E); }
        for (int tile = bid; tile < 256; tile += G) {
            const int tr = tile >> 3, tc = tile & 7, rbase = MP + tr * 64, cbase = tc * 128;
            f32x16 acc;
#pragma unroll
            for (int i = 0; i < 16; ++i) acc[i] = 0.f;
            acc = mini_gemm(lds, X1B + (size_t)rbase * DM, DM, BTG + (size_t)cbase * DM, DM, DM, tid, wave, lane, acc);
            const int wr2 = wave >> 2, wc4 = wave & 3, r = lane & 31, hh = lane >> 5;
            const int col = cbase + wc4 * 32 + r;
            float yv[16], pv2[16], rv[16];
#pragma unroll
            for (int i = 0; i < 16; ++i) { const int row = rbase + wr2 * 32 + (i & 3) + 8 * (i >> 2) + 4 * hh; const size_t off = (size_t)row * DM + col;
                yv[i] = out[O_Y + off]; pv2[i] = bf2f(PP[off]); rv[i] = R1[row]; }
#pragma unroll
            for (int i = 0; i < 16; ++i) { const int row = rbase + wr2 * 32 + (i & 3) + 8 * (i >> 2) + 4 * hh; const size_t off = (size_t)row * DM + col;
                out[O_Y + off] = yv[i] + pv2[i] * sigmoid_f(acc[i] * rv[i]); }
        }
    }
}

extern "C" void kernel_launch(void* const* d_in, const int* in_sizes, int n_in, void* d_out, int out_size, void* d_ws, size_t ws_size, hipStream_t stream) {
    static int grid_blocks = 0;
    if (grid_blocks == 0) {
        if (n_in != 18 || (size_t)out_size != O_TOTAL || ws_size < WS_END) { fprintf(stderr, "kernel_launch: unexpected shapes (n_in %d out %d ws %zu)\n", n_in, out_size, ws_size); grid_blocks = -1; return; }
        int dev = 0, cus = 0, per_cu = 0;
        hipGetDevice(&dev);
        hipDeviceGetAttribute(&cus, hipDeviceAttributeMultiprocessorCount, dev);
        hipFuncSetAttribute((const void*)fwd_kernel, hipFuncAttributeMaxDynamicSharedMemorySize, LDS_BYTES);
        hipOccupancyMaxActiveBlocksPerMultiprocessor(&per_cu, (const void*)fwd_kernel, 512, LDS_BYTES);
        if (per_cu < 1) { fprintf(stderr, "kernel_launch: occupancy query says %d blocks per CU\n", per_cu); grid_blocks = -1; return; }
        grid_blocks = cus * per_cu;
    }
    if (grid_blocks < 0) return;
    if (hipMemsetAsync((char*)d_ws + WS_BAR, 0, XCD_BAR_WORDS * 4, stream) != hipSuccess) { fprintf(stderr, "kernel_launch: memset of barrier words failed\n"); return; }
    Args a{};
    for (int i = 0; i < 18; ++i) a.in[i] = (const float*)d_in[i];
    a.out = (float*)d_out; a.ws = (unsigned char*)d_ws;
    void* args[] = {&a};
    hipError_t e = hipLaunchCooperativeKernel((const void*)fwd_kernel, dim3(grid_blocks), dim3(512), args, LDS_BYTES, stream);
    if (e != hipSuccess) fprintf(stderr, "cooperative launch failed: %s (grid %d)\n", hipGetErrorString(e), grid_blocks);
}
```

```cpp
#include <hip/hip_runtime.h>
#include <cstdio>
#include <cstdint>
#include <cstddef>

#define LAS __attribute__((address_space(3)))
typedef unsigned short bf16_t;
typedef short bf16x8 __attribute__((ext_vector_type(8)));
typedef short s16x4 __attribute__((ext_vector_type(4)));
typedef float f32x4 __attribute__((ext_vector_type(4)));
typedef float f32x16 __attribute__((ext_vector_type(16)));
typedef unsigned u32x4 __attribute__((ext_vector_type(4)));
typedef unsigned u32x2 __attribute__((ext_vector_type(2)));

constexpr int M_TOK = 34816;
constexpr int MP = 32768;
constexpr int DM = 1024;
constexpr int NIN = 10240;
constexpr int DPLE = 256;
constexpr float EPS = 1e-6f;
constexpr float QK_SCALE = 0.08838834764831845f;
constexpr int NCHUNK = M_TOK / 64;
constexpr int NCHUNK_P = MP / 64;

typedef float f32x2_t __attribute__((ext_vector_type(2))); typedef __bf16 bf16x2_t __attribute__((ext_vector_type(2)));
__device__ __forceinline__ unsigned cvt_pk_bf16(float lo, float hi) { f32x2_t v = {lo, hi}; bf16x2_t b = __builtin_convertvector(v, bf16x2_t); return __builtin_bit_cast(unsigned, b); }
__device__ __forceinline__ float bf2f(unsigned short b) { return __uint_as_float((unsigned)b << 16); }
__device__ __forceinline__ float bflo(unsigned w) { return __uint_as_float(w << 16); }
__device__ __forceinline__ float bfhi(unsigned w) { return __uint_as_float(w & 0xffff0000u); }
__device__ __forceinline__ unsigned short f2bf(float f) { unsigned u = __float_as_uint(f); return (unsigned short)((u + 0x7fffu + ((u >> 16) & 1u)) >> 16); }
__device__ __forceinline__ float sigmoid_f(float x) { return __builtin_amdgcn_rcpf(1.0f + __expf(-x)); }
__device__ __forceinline__ float silu_f(float x) { return x * sigmoid_f(x); }
__device__ __forceinline__ unsigned short f2h(float f) { _Float16 h = (_Float16)f; return __builtin_bit_cast(unsigned short, h); }
__device__ __forceinline__ float h2f(unsigned short u) { return (float)__builtin_bit_cast(_Float16, u); }
__device__ __forceinline__ float wave_sum(float v) {
#pragma unroll
    for (int o = 1; o < 64; o <<= 1) v += __shfl_xor(v, o);
    return v;
}
#define LDS_WAIT() asm volatile("s_waitcnt lgkmcnt(0)" ::: "memory")
__device__ __forceinline__ int launder(int x) { asm volatile("" : "+v"(x)); return x; }

namespace pg8 {
constexpr int BM = 256, BK = 64, HALF = 128, HTB = HALF * BK * 2, STAGE_BYTES = 8 * HTB, NXCD = 8, WGM = 8;
__host__ __device__ __forceinline__ int lds_byte(int r, int c) { const int st = (r >> 4) * 2 + (c >> 5), rr = r & 15, cc = c & 31, ob = rr * 64 + cc * 2; return st * 1024 + (ob ^ (((ob >> 9) & 1) << 5)); }
__host__ __device__ __forceinline__ void stage_rc(int b, int& R, int& C) { const int st = b / 1024, sb = b % 1024, swz = sb ^ (((sb >> 9) & 1) << 5); R = (st >> 1) * 16 + swz / 64; C = (st & 1) * 32 + (swz % 64) / 2; }
__host__ __device__ __forceinline__ int perm32(int rho) { const int n = rho >> 4, i = rho & 15; return 8 * (i >> 2) + 4 * n + (i & 3); }

struct Unit { int pm, pn; };
struct Gemm { const bf16_t* A; const bf16_t* A2; const bf16_t* Bt; int M, N, K, lda, ldb, kseg; };

struct StaticOrder {
    int nM, nN, nwg, G, c;
    __host__ __device__ void init(int M, int N, int G_, int c_) { nM = M / BM; nN = N / BM; nwg = nM * nN; G = G_; c = c_; }
    __host__ __device__ bool next(int i, Unit& u) const {
        const long L = (long)i * G + c; if (L >= nwg) return false;
        int wgid = (int)L; { const int q = nwg / NXCD, r = nwg % NXCD, xcd = wgid % NXCD, off = wgid / NXCD; wgid = (xcd < r ? xcd * (q + 1) : r * (q + 1) + (xcd - r) * q) + off; }
        const int nig = WGM * nN, gid = wgid / nig, fm = gid * WGM, gsz = (nM - fm) < WGM ? (nM - fm) : WGM;
        u.pm = fm + ((wgid % nig) % gsz); u.pn = (wgid % nig) / gsz; return true;
    }
};

template <class Epi, bool ALIGN_EPI, bool SP2>
__device__ __forceinline__ void gemm_phase(LAS unsigned char* lds, const Gemm g, const StaticOrder& S, const Epi& E) {
    const int tid = launder((int)threadIdx.x), wid = __builtin_amdgcn_readfirstlane(tid >> 6), lane = tid & 63, wr = wid >> 2, wc = wid & 3, fr = lane & 15, fq = lane >> 4;
    const int K = g.K, nt = K / BK;
    unsigned voffA[2], voffB[2];
#pragma unroll
    for (int i = 0; i < 2; ++i) { int R, C; stage_rc(tid * 16 + i * 8192, R, C); const int Rb = (R & ~31) + perm32(R & 31);
        voffA[i] = (unsigned)(R * g.lda + C) * 2u; voffB[i] = (unsigned)(Rb * g.ldb + C) * 2u; }
    const size_t kstep = (size_t)(BK * 2);
    const size_t hstepA = (size_t)HALF * g.lda * 2, hstepB = (size_t)HALF * g.ldb * 2;
    const size_t tstepA = 2 * hstepA, tstepB = 2 * hstepB;
    const ptrdiff_t segd = g.A2 ? (((const char*)g.A2 - (const char*)g.A) - (ptrdiff_t)g.kseg * (ptrdiff_t)kstep) : (ptrdiff_t)0;
    const int kseg = g.A2 ? g.kseg : (nt + 8);
    const unsigned ldsw = (unsigned)wid * 1024u;
    const int aoff = lds_byte(wr * 64 + fr, fq * 8), boff = lds_byte(wc * 32 + fr, fq * 8);
#define PG8_SA(b, h) (((b) * 2 + (h)) * HTB)
#define PG8_SB(b, h) ((4 + (b) * 2 + (h)) * HTB)
#define PG8_STAGE(bufoff, gbase, voff) do { _Pragma("unroll") for (int _i = 0; _i < 2; ++_i) \
        __builtin_amdgcn_global_load_lds((const unsigned*)((const char*)(gbase) + (voff)[_i]), (LAS unsigned*)(lds + (bufoff) + ldsw + _i * 8192), 16, 0, 0); } while (0)
#define PG8_LDA(dst, b, h) do { _Pragma("unroll") for (int m = 0; m < 4; ++m) _Pragma("unroll") for (int k = 0; k < 2; ++k) dst[m][k] = *(const LAS bf16x8*)(lds + PG8_SA(b, h) + aoff + m * 2048 + k * 1024); } while (0)
#define PG8_LDB(dst, b, h) do { _Pragma("unroll") for (int n = 0; n < 2; ++n) _Pragma("unroll") for (int k = 0; k < 2; ++k) dst[n][k] = *(const LAS bf16x8*)(lds + PG8_SB(b, h) + boff + n * 2048 + k * 1024); } while (0)
#define PG8_MMA(ai, bj, At, Bt) do { __builtin_amdgcn_s_setprio(1); _Pragma("unroll") for (int m = 0; m < 4; ++m) _Pragma("unroll") for (int n = 0; n < 2; ++n) _Pragma("unroll") for (int k = 0; k < 2; ++k) \
        acc[ai][bj][m][n] = __builtin_amdgcn_mfma_f32_16x16x32_bf16(Bt[n][k], At[m][k], acc[ai][bj][m][n], 0, 0, 0); __builtin_amdgcn_s_setprio(0); } while (0)
#define PG8_WAIT_V(n) asm volatile("s_waitcnt vmcnt(" #n ")" ::: "memory")
#define PG8_WAIT_L(n) asm volatile("s_waitcnt lgkmcnt(" #n ")" ::: "memory")
#define PG8_BAR __builtin_amdgcn_s_barrier()
#define PG8_SCHED __builtin_amdgcn_sched_barrier(0)
    Unit cur, nxt; int ui = 0;
    if (!S.next(0, cur)) return;
    f32x4 acc[2][2][4][2];
#pragma unroll
    for (int a = 0; a < 2; ++a)
#pragma unroll
        for (int b = 0; b < 2; ++b)
#pragma unroll
            for (int m = 0; m < 4; ++m)
#pragma unroll
                for (int n = 0; n < 2; ++n) acc[a][b][m][n] = (f32x4){0.f, 0.f, 0.f, 0.f};
    bf16x8 At[4][2], B0[2][2], B1[2][2];
    const char* cA = (const char*)g.A + (size_t)cur.pm * tstepA; const char* cB = (const char*)g.Bt + (size_t)cur.pn * tstepB;
    if constexpr (SP2) {
        PG8_STAGE(PG8_SB(0, 0), cB, voffB); PG8_STAGE(PG8_SB(0, 1), cB + hstepB, voffB); PG8_STAGE(PG8_SA(0, 0), cA, voffA); PG8_STAGE(PG8_SA(0, 1), cA + hstepA, voffA);
        if (wr == 1) PG8_BAR;
        PG8_WAIT_V(2); PG8_BAR;
        PG8_STAGE(PG8_SB(1, 0), cB + kstep, voffB); PG8_STAGE(PG8_SA(1, 0), cA + kstep, voffA); PG8_STAGE(PG8_SB(1, 1), cB + hstepB + kstep, voffB);
        PG8_WAIT_V(6); PG8_BAR;
    } else {
        PG8_STAGE(PG8_SB(0, 0), cB, voffB); PG8_STAGE(PG8_SA(0, 0), cA, voffA); PG8_STAGE(PG8_SB(0, 1), cB + hstepB, voffB); PG8_STAGE(PG8_SA(0, 1), cA + hstepA, voffA);
        if (wr == 1) PG8_BAR;
        PG8_WAIT_V(4); PG8_BAR;
        PG8_STAGE(PG8_SB(1, 0), cB + kstep, voffB); PG8_STAGE(PG8_SA(1, 0), cA + kstep, voffA); PG8_STAGE(PG8_SB(1, 1), cB + hstepB + kstep, voffB);
        PG8_WAIT_V(6); PG8_BAR;
    }
    for (;;) {
        const bool has_next = S.next(ui + 1, nxt);
        const char* nA = has_next ? (const char*)g.A + (size_t)nxt.pm * tstepA : cA; const char* nB = has_next ? (const char*)g.Bt + (size_t)nxt.pn * tstepB : cB;
#pragma nounroll
        for (int t = 0; t < nt; t += 2) {
            if constexpr (Epi::HAS_MID) { if (t == kseg) E.mid(acc, cur, wr, wc, fr, fq); }
            const bool last = (t == nt - 2);
            const char* a1 = cA + (size_t)(t + 1) * kstep + ((t + 1) >= kseg ? segd : (ptrdiff_t)0);
            const char* a2 = last ? nA : cA + (size_t)(t + 2) * kstep + ((t + 2) >= kseg ? segd : (ptrdiff_t)0);
            const char* b2 = last ? nB : cB + (size_t)(t + 2) * kstep;
            const char* a3 = a2 + kstep; const char* b3 = b2 + kstep;
            if constexpr (SP2) {
            PG8_LDB(B0, 0, 0); PG8_LDB(B1, 0, 1); PG8_SCHED; PG8_LDA(At, 0, 0); PG8_STAGE(PG8_SA(1, 1), a1 + hstepA, voffA);
            PG8_WAIT_V(8); PG8_WAIT_L(0); PG8_BAR; PG8_MMA(0, 0, At, B0); PG8_MMA(0, 1, At, B1); PG8_BAR; PG8_SCHED;
            PG8_LDA(At, 0, 1); PG8_STAGE(PG8_SB(0, 0), b2, voffB); PG8_STAGE(PG8_SB(0, 1), b2 + hstepB, voffB); PG8_STAGE(PG8_SA(0, 0), a2, voffA);
            PG8_WAIT_V(8); PG8_WAIT_L(0); PG8_BAR; PG8_MMA(1, 0, At, B0); PG8_MMA(1, 1, At, B1); PG8_BAR; PG8_SCHED;
            PG8_LDB(B0, 1, 0); PG8_LDB(B1, 1, 1); PG8_SCHED; PG8_LDA(At, 1, 0); PG8_STAGE(PG8_SA(0, 1), a2 + hstepA, voffA);
            PG8_WAIT_V(8); PG8_WAIT_L(0); PG8_BAR; PG8_MMA(0, 0, At, B0); PG8_MMA(0, 1, At, B1); PG8_BAR; PG8_SCHED;
            PG8_LDA(At, 1, 1); PG8_STAGE(PG8_SB(1, 0), b3, voffB); PG8_STAGE(PG8_SB(1, 1), b3 + hstepB, voffB); PG8_STAGE(PG8_SA(1, 0), a3, voffA);
            PG8_WAIT_V(8); PG8_WAIT_L(0); PG8_BAR; PG8_MMA(1, 0, At, B0); PG8_MMA(1, 1, At, B1); PG8_BAR; PG8_SCHED;
            } else {
            PG8_LDB(B0, 0, 0); PG8_SCHED; PG8_LDA(At, 0, 0); PG8_STAGE(PG8_SA(1, 1), a1 + hstepA, voffA);
            PG8_WAIT_L(8); PG8_BAR; PG8_WAIT_L(0); PG8_MMA(0, 0, At, B0); PG8_BAR; PG8_SCHED;
            PG8_LDB(B1, 0, 1); PG8_STAGE(PG8_SB(0, 0), b2, voffB);
            PG8_BAR; PG8_WAIT_L(0); PG8_MMA(0, 1, At, B1); PG8_BAR;
            PG8_LDA(At, 0, 1); PG8_STAGE(PG8_SA(0, 0), a2, voffA);
            PG8_BAR; PG8_WAIT_L(0); PG8_MMA(1, 0, At, B0); PG8_BAR; PG8_SCHED;
            PG8_STAGE(PG8_SB(0, 1), b2 + hstepB, voffB);
            PG8_WAIT_V(6); PG8_BAR; PG8_MMA(1, 1, At, B1); PG8_BAR;
            PG8_LDB(B0, 1, 0); PG8_SCHED; PG8_LDA(At, 1, 0); PG8_STAGE(PG8_SA(0, 1), a2 + hstepA, voffA);
            PG8_WAIT_L(8); PG8_BAR; PG8_WAIT_L(0); PG8_MMA(0, 0, At, B0); PG8_BAR; PG8_SCHED;
            PG8_LDB(B1, 1, 1); PG8_STAGE(PG8_SB(1, 0), b3, voffB);
            PG8_BAR; PG8_WAIT_L(0); PG8_MMA(0, 1, At, B1); PG8_BAR;
            PG8_LDA(At, 1, 1); PG8_STAGE(PG8_SA(1, 0), a3, voffA);
            PG8_BAR; PG8_WAIT_L(0); PG8_MMA(1, 0, At, B0); PG8_BAR; PG8_SCHED;
            PG8_STAGE(PG8_SB(1, 1), b3 + hstepB, voffB);
            PG8_WAIT_V(6); PG8_BAR; PG8_MMA(1, 1, At, B1); PG8_BAR;
            }
        }
        if constexpr (ALIGN_EPI) { if (wr == 0) PG8_BAR; }
        E(acc, cur, wr, wc, fr, fq);
        if (!has_next) break;
#pragma unroll
        for (int a = 0; a < 2; ++a)
#pragma unroll
            for (int b = 0; b < 2; ++b)
#pragma unroll
                for (int m = 0; m < 4; ++m)
#pragma unroll
                    for (int n = 0; n < 2; ++n) acc[a][b][m][n] = (f32x4){0.f, 0.f, 0.f, 0.f};
        cur = nxt; cA = nA; cB = nB; ++ui;
        if constexpr (ALIGN_EPI) { if (wr == 1) PG8_BAR; }
    }
    PG8_WAIT_V(0);
    if constexpr (!ALIGN_EPI) { if (wr == 0) PG8_BAR; }
    PG8_BAR;
#undef PG8_SA
#undef PG8_SB
#undef PG8_STAGE
#undef PG8_LDA
#undef PG8_LDB
#undef PG8_MMA
#undef PG8_WAIT_V
#undef PG8_WAIT_L
#undef PG8_BAR
#undef PG8_SCHED
}
}

__device__ __forceinline__ u32x4 pack8(const f32x4 a, const f32x4 b) { u32x4 w; w.x = cvt_pk_bf16(a[0], a[1]); w.y = cvt_pk_bf16(a[2], a[3]); w.z = cvt_pk_bf16(b[0], b[1]); w.w = cvt_pk_bf16(b[2], b[3]); return w; }
__device__ __forceinline__ void unpack8(const u32x4 w, f32x4& a, f32x4& b) { a = (f32x4){bflo(w.x), bfhi(w.x), bflo(w.y), bfhi(w.y)}; b = (f32x4){bflo(w.z), bfhi(w.z), bflo(w.w), bfhi(w.w)}; }

struct Epi1 {
    static constexpr bool HAS_MID = false;
    const float* rinv; const float* lbv;
    bf16_t *UF, *GA, *Q, *V, *SZ, *SGA, *SGB; unsigned short* LFH; float* conv_p; float* conv_s; const float* convw; LAS unsigned char* ldsx;
    __device__ __forceinline__ void operator()(const f32x4 (&acc)[2][2][4][2], const pg8::Unit& u, int wr, int wc, int fr, int fq) const {
        const int row0 = launder(u.pm * 256 + wr * 64 + fr);
        float rv[2][4];
#pragma unroll
        for (int ai = 0; ai < 2; ++ai)
#pragma unroll
            for (int m = 0; m < 4; ++m) rv[ai][m] = rinv[row0 + ai * 128 + m * 16];
        if (u.pn < 16) {
            const int c4 = launder(u.pn * 64 + wc * 16 + 4 * fq);
            const f32x4 w0 = *(const f32x4*)(convw + c4), w1 = *(const f32x4*)(convw + DM + c4), w2 = *(const f32x4*)(convw + 2 * DM + c4);
            LAS unsigned short* wl = (LAS unsigned short*)(ldsx + (wr * 4 + wc) * 2048);
#pragma unroll
            for (int ai = 0; ai < 2; ++ai) {
                f32x4 uu[4], gg[4];
#pragma unroll
                for (int m = 0; m < 4; ++m) {
                    const int row = row0 + ai * 128 + m * 16; const float r = rv[ai][m]; const float r2 = r * r;
                    uu[m] = acc[ai][0][m][0] * acc[ai][0][m][1] * r2;
#pragma unroll
                    for (int e = 0; e < 4; ++e) gg[m][e] = silu_f(acc[ai][1][m][1][e] * r) * (acc[ai][1][m][0][e] * r);
                    float* cdst = nullptr;
                    if (row < MP) { const int t = row & 8191; if (t >= 8190) cdst = conv_p + ((size_t)((row >> 13) * 2 + (t - 8190))) * DM + c4; }
                    else { const int rs = row - MP; const int t = rs & 63; if (t >= 62) cdst = conv_s + ((size_t)((rs >> 6) * 2 + (t - 62))) * DM + c4; }
                    if (cdst) *(f32x4*)cdst = uu[m];
                    u32x2 w; w.x = cvt_pk_bf16(uu[m][0], uu[m][1]); w.y = cvt_pk_bf16(uu[m][2], uu[m][3]);
                    *(LAS u32x2*)(wl + (16 * m + fr) * 16 + 4 * fq) = w;
                    if ((m == 0 && fr < 2) || (m == 3 && fr >= 14)) { const int slot = (m == 0) ? fr : (fr - 12);
                        *(u32x2*)(UF + ((size_t)(row >> 6) * 4 + slot) * DM + c4) = w; }
                }
                LDS_WAIT(); asm volatile("" ::: "memory");
#pragma unroll
                for (int m = 0; m < 4; ++m) {
                    const int row = row0 + ai * 128 + m * 16; const int lr = 16 * m + fr;
                    f32x4 res = gg[m];
                    if (lr >= 2) {
                        const u32x2 a1 = *(const LAS u32x2*)(wl + (lr - 1) * 16 + 4 * fq), a2 = *(const LAS u32x2*)(wl + (lr - 2) * 16 + 4 * fq);
                        const f32x4 um1 = (f32x4){bflo(a1.x), bfhi(a1.x), bflo(a1.y), bfhi(a1.y)}, um2 = (f32x4){bflo(a2.x), bfhi(a2.x), bflo(a2.y), bfhi(a2.y)};
                        res = gg[m] * (w0 * um2 + w1 * um1 + w2 * uu[m]);
                    }
                    u32x2 w; w.x = cvt_pk_bf16(res[0], res[1]); w.y = cvt_pk_bf16(res[2], res[3]);
                    *(u32x2*)(GA + (size_t)row * DM + c4) = w;
                }
                LDS_WAIT(); asm volatile("" ::: "memory");
            }
            return;
        }
        const int type = 2 + ((u.pn - 16) >> 3);
        const int ch0 = launder(((u.pn - 16) & 7) * 128 + wc * 32 + 8 * fq);
        if (type == 2) {
            const f32x4 lb0 = *(const f32x4*)(lbv + ch0), lb1 = *(const f32x4*)(lbv + ch0 + 4);
#pragma unroll
            for (int ai = 0; ai < 2; ++ai)
#pragma unroll
                for (int m = 0; m < 4; ++m) {
                    const int row = row0 + ai * 128 + m * 16; const float r = rv[ai][m];
                    f32x4 q0, q1; unsigned short lf[8];
#pragma unroll
                    for (int i = 0; i < 4; ++i) {
                        q0[i] = acc[ai][0][m][0][i] * r; q1[i] = acc[ai][0][m][1][i] * r;
                        const float f0 = lb0[i] + (1.0f - lb0[i]) * sigmoid_f(acc[ai][1][m][0][i] * r), f1 = lb1[i] + (1.0f - lb1[i]) * sigmoid_f(acc[ai][1][m][1][i] * r);
                        lf[i] = f2h(f0); lf[4 + i] = f2h(f1);
                    }
                    *(u32x4*)(Q + (size_t)row * DM + ch0) = pack8(q0, q1);
                    u32x4 w; w.x = (unsigned)lf[0] | ((unsigned)lf[1] << 16); w.y = (unsigned)lf[2] | ((unsigned)lf[3] << 16); w.z = (unsigned)lf[4] | ((unsigned)lf[5] << 16); w.w = (unsigned)lf[6] | ((unsigned)lf[7] << 16);
                    *(u32x4*)(LFH + (size_t)row * DM + ch0) = w;
                }
        } else if (type == 3) {
#pragma unroll
            for (int ai = 0; ai < 2; ++ai)
#pragma unroll
                for (int m = 0; m < 4; ++m) {
                    const int row = row0 + ai * 128 + m * 16; const float r = rv[ai][m];
                    f32x4 z0, z1;
#pragma unroll
                    for (int i = 0; i < 4; ++i) { z0[i] = acc[ai][1][m][0][i] * r; z1[i] = acc[ai][1][m][1][i] * r; }
                    *(u32x4*)(V + (size_t)row * DM + ch0) = pack8(acc[ai][0][m][0] * r, acc[ai][0][m][1] * r);
                    *(u32x4*)(SZ + (size_t)row * DM + ch0) = pack8(z0, z1);
                }
        } else {
#pragma unroll
            for (int ai = 0; ai < 2; ++ai)
#pragma unroll
                for (int m = 0; m < 4; ++m) {
                    const int row = row0 + ai * 128 + m * 16; const float r = rv[ai][m];
                    f32x4 a0, a1, b0, b1;
#pragma unroll
                    for (int i = 0; i < 4; ++i) { a0[i] = sigmoid_f(acc[ai][0][m][0][i] * r); a1[i] = sigmoid_f(acc[ai][0][m][1][i] * r); b0[i] = sigmoid_f(acc[ai][1][m][0][i] * r); b1[i] = sigmoid_f(acc[ai][1][m][1][i] * r); }
                    *(u32x4*)(SGA + (size_t)row * DM + ch0) = pack8(a0, a1);
                    *(u32x4*)(SGB + (size_t)row * DM + ch0) = pack8(b0, b1);
                }
        }
    }
};

struct EpiMerge {
    static constexpr bool HAS_MID = true;
    const bf16_t *SGA, *SGB; bf16_t* MG;
    __device__ __forceinline__ void mid(f32x4 (&acc)[2][2][4][2], const pg8::Unit& u, int wr, int wc, int fr, int fq) const {
        const int row0 = launder(u.pm * 256 + wr * 64 + fr), colb = launder(u.pn * 256 + wc * 32 + 8 * fq);
#pragma unroll
        for (int ai = 0; ai < 2; ++ai) {
            u32x4 la[4][2], lb[4][2];
#pragma unroll
            for (int m = 0; m < 4; ++m)
#pragma unroll
                for (int bj = 0; bj < 2; ++bj) { const size_t off = (size_t)(row0 + ai * 128 + m * 16) * DM + colb + bj * 128;
                    la[m][bj] = __builtin_nontemporal_load((const u32x4*)(SGA + off)); lb[m][bj] = *(const u32x4*)(SGB + off); }
#pragma unroll
            for (int m = 0; m < 4; ++m)
#pragma unroll
                for (int bj = 0; bj < 2; ++bj) {
                    f32x4 a0, a1, b0, b1; unpack8(la[m][bj], a0, a1); unpack8(lb[m][bj], b0, b1);
#pragma unroll
                    for (int i = 0; i < 4; ++i) { acc[ai][bj][m][0][i] *= a0[i] * __builtin_amdgcn_rcpf(b0[i]); acc[ai][bj][m][1][i] *= a1[i] * __builtin_amdgcn_rcpf(b1[i]); }
                }
            asm volatile("" : "+v"(acc[ai][0][0][0]), "+v"(acc[ai][1][3][1]) :: "memory");
        }
    }
    __device__ __forceinline__ void operator()(const f32x4 (&acc)[2][2][4][2], const pg8::Unit& u, int wr, int wc, int fr, int fq) const {
        const int row0 = launder(u.pm * 256 + wr * 64 + fr), colb = launder(u.pn * 256 + wc * 32 + 8 * fq);
#pragma unroll
        for (int ai = 0; ai < 2; ++ai) {
            u32x4 lb[4][2];
#pragma unroll
            for (int m = 0; m < 4; ++m)
#pragma unroll
                for (int bj = 0; bj < 2; ++bj) lb[m][bj] = __builtin_nontemporal_load((const u32x4*)(SGB + (size_t)(row0 + ai * 128 + m * 16) * DM + colb + bj * 128));
#pragma unroll
            for (int m = 0; m < 4; ++m)
#pragma unroll
                for (int bj = 0; bj < 2; ++bj) { const size_t off = (size_t)(row0 + ai * 128 + m * 16) * DM + colb + bj * 128;
                    f32x4 b0, b1; unpack8(lb[m][bj], b0, b1);
                    *(u32x4*)(MG + off) = pack8(acc[ai][bj][m][0] * b0, acc[ai][bj][m][1] * b1); }
            asm volatile("" ::: "memory");
        }
    }
};

struct EpiO {
    static constexpr bool HAS_MID = false;
    bf16_t* OUT; float* SSQ;
    __device__ __forceinline__ void operator()(const f32x4 (&acc)[2][2][4][2], const pg8::Unit& u, int wr, int wc, int fr, int fq) const {
        const int row0 = launder(u.pm * 256 + wr * 64 + fr), colb = launder(u.pn * 256 + wc * 32 + 8 * fq);
#pragma unroll
        for (int ai = 0; ai < 2; ++ai)
#pragma unroll
            for (int m = 0; m < 4; ++m) {
                const int row = row0 + ai * 128 + m * 16; float s = 0.f;
#pragma unroll
                for (int bj = 0; bj < 2; ++bj) {
                    const f32x4 v0 = acc[ai][bj][m][0], v1 = acc[ai][bj][m][1];
                    *(u32x4*)(OUT + (size_t)row * DM + colb + bj * 128) = pack8(v0, v1);
                    s += (v0[0] * v0[0] + v0[1] * v0[1]) + (v0[2] * v0[2] + v0[3] * v0[3]) + (v1[0] * v1[0] + v1[1] * v1[1]) + (v1[2] * v1[2] + v1[3] * v1[3]);
                }
                s += __shfl_xor(s, 16); s += __shfl_xor(s, 32);
                if (fq == 0) SSQ[(size_t)row * 16 + u.pn * 4 + wc] = s;
            }
    }
};

struct EpiPP {
    static constexpr bool HAS_MID = false;
    bf16_t* PP;
    __device__ __forceinline__ void operator()(const f32x4 (&acc)[2][2][4][2], const pg8::Unit& u, int wr, int wc, int fr, int fq) const {
        const int row0 = launder(u.pm * 256 + wr * 64 + fr), colb = launder(u.pn * 256 + wc * 32 + 8 * fq);
#pragma unroll
        for (int ai = 0; ai < 2; ++ai)
#pragma unroll
            for (int m = 0; m < 4; ++m)
#pragma unroll
                for (int bj = 0; bj < 2; ++bj) {
                    const size_t off = (size_t)(row0 + ai * 128 + m * 16) * DM + colb + bj * 128;
                    *(u32x4*)(PP + off) = pack8(acc[ai][bj][m][0], acc[ai][bj][m][1]);
                }
    }
};

struct EpiFinal {
    static constexpr bool HAS_MID = false;
    const float* R1; const float* RS; const bf16_t* PP; const bf16_t* OUT; const float* X; const float* gpost; float* Y;
    __device__ __forceinline__ void operator()(const f32x4 (&acc)[2][2][4][2], const pg8::Unit& u, int wr, int wc, int fr, int fq) const {
        const int row0 = launder(u.pm * 256 + wr * 64 + fr), colb = launder(u.pn * 256 + wc * 32 + 8 * fq);
        f32x4 g[2][2];
#pragma unroll
        for (int bj = 0; bj < 2; ++bj) { g[bj][0] = *(const f32x4*)(gpost + colb + bj * 128); g[bj][1] = *(const f32x4*)(gpost + colb + bj * 128 + 4); }
#pragma unroll
        for (int ai = 0; ai < 2; ++ai)
#pragma unroll
            for (int mp = 0; mp < 2; ++mp) {
                u32x4 lp[2][2], lo[2][2]; f32x4 lx[2][2][2]; float rr[2], rsv[2];
#pragma unroll
                for (int mm = 0; mm < 2; ++mm) { const int row = row0 + ai * 128 + (2 * mp + mm) * 16; rr[mm] = R1[row]; rsv[mm] = RS[row];
#pragma unroll
                    for (int bj = 0; bj < 2; ++bj) { const size_t off = (size_t)row * DM + colb + bj * 128;
                        lp[mm][bj] = __builtin_nontemporal_load((const u32x4*)(PP + off)); lo[mm][bj] = __builtin_nontemporal_load((const u32x4*)(OUT + off));
                        lx[mm][bj][0] = __builtin_nontemporal_load((const f32x4*)(X + off)); lx[mm][bj][1] = __builtin_nontemporal_load((const f32x4*)(X + off + 4)); } }
#pragma unroll
                for (int mm = 0; mm < 2; ++mm) { const int m = 2 * mp + mm; const int row = row0 + ai * 128 + m * 16; const float r = rr[mm], rs = rsv[mm];
#pragma unroll
                    for (int bj = 0; bj < 2; ++bj) { const size_t off = (size_t)row * DM + colb + bj * 128;
                        f32x4 p0, p1, o0, o1; unpack8(lp[mm][bj], p0, p1); unpack8(lo[mm][bj], o0, o1);
                        f32x4 y0 = lx[mm][bj][0] + o0 * rs * g[bj][0], y1 = lx[mm][bj][1] + o1 * rs * g[bj][1];
#pragma unroll
                        for (int i = 0; i < 4; ++i) { y0[i] += p0[i] * sigmoid_f(acc[ai][bj][m][0][i] * r); y1[i] += p1[i] * sigmoid_f(acc[ai][bj][m][1][i] * r); }
                        __builtin_nontemporal_store(y0, (f32x4*)(Y + off)); __builtin_nontemporal_store(y1, (f32x4*)(Y + off + 4)); } }
                asm volatile("" ::: "memory");
            }
    }
};

constexpr size_t MiB = 1u << 20;
constexpr size_t BUF = (size_t)M_TOK * DM * 2;
constexpr size_t WS_GA = 0, WS_Q = 68 * MiB, WS_LFH = 136 * MiB, WS_V = 204 * MiB, WS_SZ = 272 * MiB, WS_U = 340 * MiB, WS_XB = 408 * MiB, WS_BTIN = 476 * MiB;
constexpr size_t WS_BTAB = 496 * MiB, WS_BTO = 500 * MiB, WS_BTG = 502 * MiB, WS_BTP = 504 * MiB;
constexpr size_t WS_RINV = 505 * MiB, WS_R1 = WS_RINV + 256 * 1024, WS_LBV = WS_R1 + 256 * 1024, WS_DEC = 506 * MiB, WS_SSQ = 509 * MiB, WS_END = 512 * MiB;
constexpr size_t WS_SSQ2 = WS_DEC + 1 * MiB;
constexpr size_t WS_BAR = 511 * MiB + 512 * 1024;
constexpr size_t WS_DST = WS_U;
constexpr size_t WS_MG = WS_U;
constexpr size_t WS_OUT = WS_Q;
constexpr size_t WS_X1B = WS_V;
constexpr size_t WS_PB = WS_BTIN;
constexpr size_t WS_PP = WS_XB;
static_assert(BUF == 68 * MiB, "buffer size");
static_assert(WS_DEC + (size_t)NCHUNK * 8 * 128 * 4 <= WS_SSQ && WS_SSQ + (size_t)M_TOK * 16 * 4 <= WS_END, "ws map");
constexpr size_t O_Y = 0, O_CONVP = (size_t)M_TOK * DM, O_HP = O_CONVP + 4 * 2 * 1024, O_CONVS = O_HP + (size_t)4 * 8 * 128 * 128, O_HS = O_CONVS + 32 * 2 * 1024;
constexpr size_t O_TOTAL = O_HS + (size_t)32 * 8 * 128 * 128;

struct Args { const float* in[18]; float* out; unsigned char* ws; };

__device__ __forceinline__ void p0_transpose(const float* W, int N, const float* scale, bf16_t* dst, int ldk, int koff, int dstrow0, int k0, int n0, LAS float* scr, int lane, bool amap = false) {
    float wv[32], sv[32];
#pragma unroll
    for (int i = 0; i < 32; ++i) { const int kk = 2 * i + (lane >> 5); wv[i] = __builtin_nontemporal_load(W + (size_t)(k0 + kk) * N + n0 + (lane & 31)); sv[i] = scale ? scale[k0 + kk] : 1.0f; }
#pragma unroll
    for (int i = 0; i < 32; ++i) { const int kk = 2 * i + (lane >> 5); scr[kk * 33 + (lane & 31)] = wv[i] * sv[i]; }
    LDS_WAIT(); asm volatile("" ::: "memory");
    const int c = lane & 7;
#pragma unroll
    for (int j = 0; j < 4; ++j) { const int n = (lane >> 3) + 8 * j; const LAS float* s = scr + (8 * c) * 33 + n;
        u32x4 o; o.x = cvt_pk_bf16(s[0 * 33], s[1 * 33]); o.y = cvt_pk_bf16(s[2 * 33], s[3 * 33]); o.z = cvt_pk_bf16(s[4 * 33], s[5 * 33]); o.w = cvt_pk_bf16(s[6 * 33], s[7 * 33]);
        const int nr = amap ? (32 * (n >> 4) + 8 * ((n >> 2) & 3) + (n & 3)) : n;
        *(u32x4*)(dst + (size_t)(dstrow0 + nr) * ldk + koff + k0 + 8 * c) = o; }
    LDS_WAIT(); asm volatile("" ::: "memory");
}

#define VT_GRP(v_, g_) ((((g_) ^ (((v_) >> 3) & 7)) << 3))
constexpr int NSC = 4;
constexpr int NSU = (NCHUNK_P / NSC) * 8;
constexpr int NSMP = (NCHUNK - NCHUNK_P) * 8;
__device__ __forceinline__ void step_map(int j, int nps, int bid, int G, int& un, int& su, bool& first, bool& last) {
    if (j < nps) { const int i = j / NSC, c = j % NSC; su = bid + G * i; un = (((su >> 3) * NSC + c) << 3) + (su & 7); first = (c == 0); last = (c == NSC - 1); }
    else { su = -1; un = NCHUNK_P * 8 + bid + G * (j - nps); first = true; last = true; }
}
__device__ __forceinline__ void p2b_scan(const LAS unsigned short* LF, LAS unsigned short* kd, LAS float* decs, float* decg, bool first, bool last, float& dprod, int tid) {
    const int k = tid & 127, tq = tid >> 7;
    float fv[16];
#pragma unroll
    for (int j = 0; j < 16; ++j) fv[j] = h2f(LF[(tq * 16 + j) * 136 + k]);
    float er = 1.0f;
    for (int q2 = tq + 1; q2 < 4; ++q2) {
#pragma unroll
        for (int j = 0; j < 16; ++j) er *= h2f(LF[(q2 * 16 + j) * 136 + k]);
    }
    float kv[16];
#pragma unroll
    for (int j = 15; j >= 0; --j) { kv[j] = (1.0f - fv[j]) * er; er *= fv[j]; }
    u32x4 w0, w1;
    w0.x = cvt_pk_bf16(kv[0], kv[1]); w0.y = cvt_pk_bf16(kv[2], kv[3]); w0.z = cvt_pk_bf16(kv[4], kv[5]); w0.w = cvt_pk_bf16(kv[6], kv[7]);
    w1.x = cvt_pk_bf16(kv[8], kv[9]); w1.y = cvt_pk_bf16(kv[10], kv[11]); w1.z = cvt_pk_bf16(kv[12], kv[13]); w1.w = cvt_pk_bf16(kv[14], kv[15]);
    *(LAS u32x4*)(kd + k * 72 + tq * 16) = w0; *(LAS u32x4*)(kd + k * 72 + tq * 16 + 8) = w1;
    if (tq == 0) { const float d = er; decs[k] = d; dprod = first ? d : dprod * d; if (last && decg) decg[k] = dprod; }
}
__device__ __forceinline__ void p2b_mfma(const LAS unsigned short* kd, const LAS unsigned short* vT, const LAS float* decs, int un, int su, bool first, bool last,
                                         f32x16& acc0, f32x16& acc1, bf16_t* DST, const float* st_hgrn, float* out_hs, int wave, int lane) {
    const int cidx = un >> 3, h = un & 7;
    const int kt = wave >> 1, vt0 = (wave & 1) * 2, r = lane & 31, hh = lane >> 5;
    const int v0 = vt0 * 32 + r, v1 = v0 + 32;
    if (first) {
#pragma unroll
        for (int i = 0; i < 16; ++i) { acc0[i] = 0.f; acc1[i] = 0.f; }
    } else {
#pragma unroll
        for (int i = 0; i < 16; ++i) { const float d = decs[kt * 32 + (i & 3) + 8 * (i >> 2) + 4 * hh]; acc0[i] *= d; acc1[i] *= d; }
    }
#pragma unroll
    for (int ks = 0; ks < 4; ++ks) {
        const bf16x8 af = *(const LAS bf16x8*)(kd + (kt * 32 + r) * 72 + 16 * ks + 8 * hh);
        const bf16x8 b0 = *(const LAS bf16x8*)(vT + v0 * 72 + VT_GRP(v0, 2 * ks + hh));
        const bf16x8 b1 = *(const LAS bf16x8*)(vT + v1 * 72 + VT_GRP(v1, 2 * ks + hh));
        acc0 = __builtin_amdgcn_mfma_f32_32x32x16_bf16(af, b0, acc0, 0, 0, 0);
        acc1 = __builtin_amdgcn_mfma_f32_32x32x16_bf16(af, b1, acc1, 0, 0, 0);
    }
    if (!last) return;
    if (su >= 0) {
        bf16_t* dp = DST + (size_t)su * 16384 + (kt * 4 + vt0) * 1024 + lane * 4;
#pragma unroll
        for (int q = 0; q < 4; ++q) {
            u32x2 w0, w1; w0.x = cvt_pk_bf16(acc0[4 * q], acc0[4 * q + 1]); w0.y = cvt_pk_bf16(acc0[4 * q + 2], acc0[4 * q + 3]);
            w1.x = cvt_pk_bf16(acc1[4 * q], acc1[4 * q + 1]); w1.y = cvt_pk_bf16(acc1[4 * q + 2], acc1[4 * q + 3]);
            *(u32x2*)(dp + q * 256) = w0; *(u32x2*)(dp + 1024 + q * 256) = w1; }
    } else {
        const size_t sbase = ((size_t)(cidx - NCHUNK_P) * 8 + h) * 16384;
        const float* s0 = st_hgrn + sbase; float* so = out_hs + sbase;
        float p0[16], p1[16];
#pragma unroll
        for (int i = 0; i < 16; ++i) { const int k = kt * 32 + (i & 3) + 8 * (i >> 2) + 4 * hh; p0[i] = s0[k * 128 + v0]; p1[i] = s0[k * 128 + v1]; }
#pragma unroll
        for (int i = 0; i < 16; ++i) { const int k = kt * 32 + (i & 3) + 8 * (i >> 2) + 4 * hh; const float d = decs[k];
            so[k * 128 + v0] = d * p0[i] + acc0[i]; so[k * 128 + v1] = d * p1[i] + acc1[i]; }
    }
}

__device__ __forceinline__ f32x16 mini_gemm(LAS unsigned char* lds, const bf16_t* A, int lda, const bf16_t* Bt, int ldb, int K, int tid, int wave, int lane, f32x16 acc) {
    LAS unsigned short* As0 = (LAS unsigned short*)lds;
    LAS unsigned short* Bs0 = (LAS unsigned short*)(lds + 2 * 9216);
    const int lr = tid >> 3, lp = (tid & 7) * 8;
    const bf16_t* ap = A + (size_t)lr * lda + lp;
    const bf16_t* bp0 = Bt + (size_t)lr * ldb + lp; const bf16_t* bp1 = Bt + (size_t)(lr + 64) * ldb + lp;
    const int nk = K / 64;
    u32x4 ra[4], rb0[4], rb1[4];
#pragma unroll
    for (int s = 0; s < 4; ++s) { ra[s] = *(const u32x4*)(ap + 64 * s); rb0[s] = *(const u32x4*)(bp0 + 64 * s); rb1[s] = *(const u32x4*)(bp1 + 64 * s); }
    *(LAS u32x4*)(As0 + lr * 72 + lp) = ra[0]; *(LAS u32x4*)(Bs0 + lr * 72 + lp) = rb0[0]; *(LAS u32x4*)(Bs0 + (lr + 64) * 72 + lp) = rb1[0];
    __syncthreads();
    const int wr2 = wave >> 2, wc4 = wave & 3, r = lane & 31, hh = lane >> 5;
    for (int kt0 = 0; kt0 < nk; kt0 += 4) {
#pragma unroll
        for (int u = 0; u < 4; ++u) {
            const int kt = kt0 + u;
            if (kt + 4 < nk) { const int ko = (kt + 4) * 64; ra[u] = *(const u32x4*)(ap + ko); rb0[u] = *(const u32x4*)(bp0 + ko); rb1[u] = *(const u32x4*)(bp1 + ko); }
            const LAS unsigned short* As = As0 + (u & 1) * (64 * 72); const LAS unsigned short* Bs = Bs0 + (u & 1) * (128 * 72);
#pragma unroll
            for (int ks = 0; ks < 4; ++ks) {
                const bf16x8 af = *(const LAS bf16x8*)(As + (wr2 * 32 + r) * 72 + 16 * ks + 8 * hh);
                const bf16x8 bfr = *(const LAS bf16x8*)(Bs + (wc4 * 32 + r) * 72 + 16 * ks + 8 * hh);
                acc = __builtin_amdgcn_mfma_f32_32x32x16_bf16(af, bfr, acc, 0, 0, 0);
            }
            if (kt + 1 < nk) {
                LAS unsigned short* An = As0 + ((u + 1) & 1) * (64 * 72); LAS unsigned short* Bn = Bs0 + ((u + 1) & 1) * (128 * 72);
                *(LAS u32x4*)(An + lr * 72 + lp) = ra[(u + 1) & 3]; *(LAS u32x4*)(Bn + lr * 72 + lp) = rb0[(u + 1) & 3]; *(LAS u32x4*)(Bn + (lr + 64) * 72 + lp) = rb1[(u + 1) & 3];
            }
            __syncthreads();
        }
    }
    return acc;
}

#define XB_TMO      128
#define XB_XCNT(j)  (256  + 64 * (j))
#define XB_XSUB(j)  (1280 + 64 * (j))
#define XB_XGEN(j)  (2304 + 64 * (j))
#define XB_TOP      3328
#define XB_TOPGEN   3392
#define XCD_BAR_WORDS 3456
#define XB_SPIN_CAP (1u << 18)
__device__ __forceinline__ unsigned xb_ld(unsigned* p)              { return __hip_atomic_load(p, __ATOMIC_RELAXED, __HIP_MEMORY_SCOPE_AGENT); }
__device__ __forceinline__ unsigned xb_add(unsigned* p, unsigned v) { return __hip_atomic_fetch_add(p, v, __ATOMIC_RELAXED, __HIP_MEMORY_SCOPE_AGENT); }
__device__ __forceinline__ unsigned xb_xcc_id() { return (unsigned)__builtin_amdgcn_s_getreg((3 << 11) | 20) & 0xFu; }
#define XB_SPIN(cond, bar) do { unsigned _sp = 0; while (cond) { __builtin_amdgcn_s_sleep(1); \
    if ((++_sp & 255u) == 0u) { if (xb_ld(&(bar)[XB_TMO])) break; if (_sp > XB_SPIN_CAP) { atomicAdd(&(bar)[XB_TMO], 1u); break; } } } } while (0)
struct XcdBarrier { unsigned* bar; unsigned x; volatile LAS unsigned* st; };
__device__ __forceinline__ XcdBarrier xcd_barrier_post(unsigned* bar, volatile LAS unsigned* st) {
    XcdBarrier b; b.bar = bar; b.x = xb_xcc_id(); b.st = st;
    if (threadIdx.x == 0) (void)xb_add(&bar[XB_XCNT(b.x)], 1u);
    return b;
}
__device__ __forceinline__ void xcd_barrier_complete(unsigned* bar, unsigned x, unsigned& nloc, unsigned& nx) {
    const unsigned G = gridDim.x * gridDim.y * gridDim.z;
    unsigned sum, cnt, mine, sp = 0u;
    for (;;) {
        sum = 0u; cnt = 0u; mine = 0u;
#pragma unroll
        for (unsigned j = 0; j < 16; ++j) { const unsigned c = xb_ld(&bar[XB_XCNT(j)]); sum += c; cnt += (c > 0u) ? 1u : 0u; mine = (j == x) ? c : mine; }
        if (sum == G) break;
        __builtin_amdgcn_s_sleep(1);
        if ((++sp & 255u) == 0u) { if (xb_ld(&bar[XB_TMO])) break; if (sp > XB_SPIN_CAP) { atomicAdd(&bar[XB_TMO], 1u); break; } }
    }
    nloc = mine > 0u ? mine : 1u; nx = cnt > 0u ? cnt : 1u;
}
__device__ __forceinline__ void xcd_barrier(const XcdBarrier& b) {
    asm volatile("s_waitcnt vmcnt(0)" ::: "memory");
    __syncthreads();
    if (threadIdx.x == 0) {
        unsigned* bar = b.bar;
        __builtin_amdgcn_s_waitcnt(0);
        unsigned nloc = b.st[0], nx = b.st[1];
        if (nloc == 0u) { xcd_barrier_complete(bar, b.x, nloc, nx); b.st[0] = nloc; b.st[1] = nx; }
        const unsigned old = xb_add(&bar[XB_XSUB(b.x)], 1u);
        const unsigned gen = old / nloc;
        if (old + 1u == (gen + 1u) * nloc) {
            __builtin_amdgcn_fence(__ATOMIC_RELEASE, "agent");
            asm volatile("s_waitcnt vmcnt(0)" ::: "memory");
            const unsigned og = xb_add(&bar[XB_TOP], 1u);
            const unsigned tg = og / nx;
            if (og + 1u == (tg + 1u) * nx) xb_add(&bar[XB_TOPGEN], 1u);
            else XB_SPIN(xb_ld(&bar[XB_TOPGEN]) == tg, bar);
            __builtin_amdgcn_fence(__ATOMIC_ACQUIRE, "agent");
            xb_add(&bar[XB_XGEN(b.x)], 1u);
            asm volatile("s_waitcnt vmcnt(0)" ::: "memory");
        } else {
            XB_SPIN(xb_ld(&bar[XB_XGEN(b.x)]) == gen, bar);
            __builtin_amdgcn_fence(__ATOMIC_ACQUIRE, "agent");
            asm volatile("s_waitcnt vmcnt(0)" ::: "memory");
        }
    }
    __syncthreads();
}
#define GSYNC() xcd_barrier(bar)

constexpr int LDS_BYTES = 148480;

__global__ void __launch_bounds__(512, 2) fwd_kernel(Args a) {
    extern __shared__ __attribute__((aligned(16))) unsigned char lds_raw[];
    LAS unsigned char* lds = (LAS unsigned char*)lds_raw;
    const int tid = threadIdx.x, lane = tid & 63, wave = __builtin_amdgcn_readfirstlane(tid >> 6);
    const int G = gridDim.x, bid = blockIdx.x;
    const int gw = bid * 8 + wave, NGW = G * 8;
    const int gt = bid * 512 + tid, NGT = G * 512;
    volatile LAS unsigned* stw = (volatile LAS unsigned*)(lds + LDS_BYTES - 16);
    if (tid < 4) stw[tid] = 0u;
    __syncthreads();
    const XcdBarrier bar = xcd_barrier_post((unsigned*)(a.ws + WS_BAR), stw);

    const float* x_p = a.in[0]; const float* x_s = a.in[1]; const float* st_conv = a.in[2]; const float* st_hgrn = a.in[3];
    const float* p_p = a.in[4]; const float* p_s = a.in[5]; const float* w_in = a.in[6]; const float* conv_w = a.in[7]; const float* lb_raw = a.in[8];
    const float* g_pre = a.in[9]; const float* g_onorm = a.in[10]; const float* w_a_out = a.in[11]; const float* w_b_out = a.in[12]; const float* w_o = a.in[13];
    const float* g_post = a.in[14]; const float* g_ple = a.in[15]; const float* w_ple_gate = a.in[16]; const float* w_ple_proj = a.in[17];
    unsigned char* ws = a.ws; float* out = a.out;
    bf16_t* GA = (bf16_t*)(ws + WS_GA); bf16_t* Q = (bf16_t*)(ws + WS_Q); unsigned short* LFH = (unsigned short*)(ws + WS_LFH); bf16_t* V = (bf16_t*)(ws + WS_V);
    bf16_t* SZ = (bf16_t*)(ws + WS_SZ); bf16_t* UF = (bf16_t*)(ws + WS_U + 40 * MiB);    bf16_t* XB = (bf16_t*)(ws + WS_XB);
    bf16_t* BTIN = (bf16_t*)(ws + WS_BTIN); bf16_t* BTAB = (bf16_t*)(ws + WS_BTAB); bf16_t* BTO = (bf16_t*)(ws + WS_BTO); bf16_t* BTG = (bf16_t*)(ws + WS_BTG); bf16_t* BTP = (bf16_t*)(ws + WS_BTP);
    float* RINV = (float*)(ws + WS_RINV); float* R1 = (float*)(ws + WS_R1); float* LBV = (float*)(ws + WS_LBV); float* DEC = (float*)(ws + WS_DEC); float* SSQ = (float*)(ws + WS_SSQ); float* SSQ2 = (float*)(ws + WS_SSQ2);
    bf16_t* DST = (bf16_t*)(ws + WS_DST); bf16_t* MG = (bf16_t*)(ws + WS_MG); bf16_t* OUTB = (bf16_t*)(ws + WS_OUT); bf16_t* X1B = (bf16_t*)(ws + WS_X1B);
    bf16_t* PB = (bf16_t*)(ws + WS_PB); bf16_t* PP = (bf16_t*)(ws + WS_PP);
    bf16_t* SGA = (bf16_t*)(out + O_Y); bf16_t* SGB = (bf16_t*)((unsigned char*)(out + O_Y) + BUF);

    {
        LAS float* scr = (LAS float*)(lds + wave * 16384);
        constexpr int I_IN = 16 * 320, I_SQ = 16 * 32, I_P = 4 * 32;
        constexpr int NITEMS = I_IN + 4 * I_SQ + I_P;
        for (int it = gw; it < NITEMS; it += NGW) {
            int r = it;
            if (r < I_IN) {
                const int kb = r / 320, nb = r % 320, n0 = nb * 32, seg = n0 >> 10, ch = n0 & 1023;
                if (seg < 4) {
                    const int kind = ((seg & 1) << 1) | (seg >> 1);
                    const int drowa = (ch >> 6) * 256 + 128 * (kind >> 1) + 32 * ((ch >> 4) & 3) + 4 * (kind & 1);
                    p0_transpose(w_in, NIN, g_pre, BTIN, DM, 0, drowa, kb * 64, n0, scr, lane, true); continue; }
                const int code = seg;
                const int drow = (((code >> 1) * 8 + (ch >> 7)) * 256) + (code & 1) * 128 + (ch & 127);
                p0_transpose(w_in, NIN, g_pre, BTIN, DM, 0, drow, kb * 64, n0, scr, lane); continue; }
            r -= I_IN;
            if (r < I_SQ) { p0_transpose(w_a_out, DM, nullptr, BTAB, 2048, 0, (r % 32) * 32, (r / 32) * 64, (r % 32) * 32, scr, lane); continue; } r -= I_SQ;
            if (r < I_SQ) { p0_transpose(w_b_out, DM, g_onorm, BTAB, 2048, 1024, (r % 32) * 32, (r / 32) * 64, (r % 32) * 32, scr, lane); continue; } r -= I_SQ;
            if (r < I_SQ) { p0_transpose(w_o, DM, nullptr, BTO, DM, 0, (r % 32) * 32, (r / 32) * 64, (r % 32) * 32, scr, lane); continue; } r -= I_SQ;
            if (r < I_SQ) { p0_transpose(w_ple_gate, DM, g_ple, BTG, DM, 0, (r % 32) * 32, (r / 32) * 64, (r % 32) * 32, scr, lane); continue; } r -= I_SQ;
            p0_transpose(w_ple_proj, DM, nullptr, BTP, DPLE, 0, (r % 32) * 32, (r / 32) * 64, (r % 32) * 32, scr, lane);
        }
        for (int m0 = gw; m0 < M_TOK; m0 += 2 * NGW) {
            const int m1 = m0 + NGW; const bool has1 = m1 < M_TOK; const int m1c = has1 ? m1 : m0;
            const f32x4* xr0 = (const f32x4*)((m0 < MP) ? x_p + (size_t)m0 * DM : x_s + (size_t)(m0 - MP) * DM) + lane;
            const f32x4* xr1 = (const f32x4*)((m1c < MP) ? x_p + (size_t)m1c * DM : x_s + (size_t)(m1c - MP) * DM) + lane;
            f32x4 v0[4], v1[4]; float s0 = 0.f, s1 = 0.f;
#pragma unroll
            for (int j = 0; j < 4; ++j) { v0[j] = __builtin_nontemporal_load(xr0 + 64 * j); v1[j] = __builtin_nontemporal_load(xr1 + 64 * j); }
#pragma unroll
            for (int j = 0; j < 4; ++j) { s0 += (v0[j][0] * v0[j][0] + v0[j][1] * v0[j][1]) + (v0[j][2] * v0[j][2] + v0[j][3] * v0[j][3]);
                                          s1 += (v1[j][0] * v1[j][0] + v1[j][1] * v1[j][1]) + (v1[j][2] * v1[j][2] + v1[j][3] * v1[j][3]); }
            s0 = wave_sum(s0); s1 = wave_sum(s1);
            if (lane == 0) { RINV[m0] = rsqrtf(s0 * (1.0f / DM) + EPS); if (has1) RINV[m1] = rsqrtf(s1 * (1.0f / DM) + EPS); }
            u32x2* o0 = (u32x2*)(XB + (size_t)m0 * DM) + lane; u32x2* o1 = (u32x2*)(XB + (size_t)m1c * DM) + lane;
#pragma unroll
            for (int j = 0; j < 4; ++j) { u32x2 w; w.x = cvt_pk_bf16(v0[j][0], v0[j][1]); w.y = cvt_pk_bf16(v0[j][2], v0[j][3]); o0[64 * j] = w; }
            if (has1) {
#pragma unroll
                for (int j = 0; j < 4; ++j) { u32x2 w; w.x = cvt_pk_bf16(v1[j][0], v1[j][1]); w.y = cvt_pk_bf16(v1[j][2], v1[j][3]); o1[64 * j] = w; }
            }
        }
        if (bid == 0) for (int j = tid; j < 1024; j += 512) { const float e0 = __expf(lb_raw[j]), e1 = __expf(lb_raw[1024 + j]); LBV[j] = e0 / (e0 + e1); }
    }
    GSYNC();

    {
        pg8::Gemm g{XB, nullptr, BTIN, M_TOK, NIN, DM, DM, DM, 0}; pg8::StaticOrder S; S.init(M_TOK, NIN, G, bid);
        Epi1 E{RINV, LBV, UF, GA, Q, V, SZ, SGA, SGB, LFH, out + O_CONVP, out + O_CONVS, conv_w, lds + 131072};
        pg8::gemm_phase<Epi1, true, true>(lds, g, S, E);
    }
    GSYNC();

    {
        for (int it = gt; it < (M_TOK / 64) * 2 * 128; it += NGT) {
            const int c8 = (it & 127) * 8, t = (it >> 7) & 1, blk = it >> 8; const int row = blk * 64 + t;
            const bool seq0 = (blk >= NCHUNK_P) || ((blk & 127) == 0);
            f32x4 u2a, u2b, u1a, u1b, u0a, u0b;
            unpack8(*(const u32x4*)(UF + ((size_t)blk * 4 + t) * DM + c8), u2a, u2b);
            if (t == 1) unpack8(*(const u32x4*)(UF + ((size_t)blk * 4 + 0) * DM + c8), u1a, u1b);
            else if (!seq0) unpack8(*(const u32x4*)(UF + ((size_t)(blk - 1) * 4 + 3) * DM + c8), u1a, u1b);
            else if (blk >= NCHUNK_P) { const float* hp = st_conv + ((size_t)(blk - NCHUNK_P) * 2 + 1) * DM + c8; u1a = *(const f32x4*)hp; u1b = *(const f32x4*)(hp + 4); }
            else { u1a = (f32x4){0.f, 0.f, 0.f, 0.f}; u1b = u1a; }
            if (!seq0) unpack8(*(const u32x4*)(UF + ((size_t)(blk - 1) * 4 + 2 + t) * DM + c8), u0a, u0b);
            else if (blk >= NCHUNK_P) { const float* hp = st_conv + ((size_t)(blk - NCHUNK_P) * 2 + t) * DM + c8; u0a = *(const f32x4*)hp; u0b = *(const f32x4*)(hp + 4); }
            else { u0a = (f32x4){0.f, 0.f, 0.f, 0.f}; u0b = u0a; }
            const f32x4 w0a = *(const f32x4*)(conv_w + c8), w0b = *(const f32x4*)(conv_w + c8 + 4);
            const f32x4 w1a = *(const f32x4*)(conv_w + DM + c8), w1b = *(const f32x4*)(conv_w + DM + c8 + 4);
            const f32x4 w2a = *(const f32x4*)(conv_w + 2 * DM + c8), w2b = *(const f32x4*)(conv_w + 2 * DM + c8 + 4);
            f32x4 ga, gb; u32x4* gp = (u32x4*)(GA + (size_t)row * DM + c8); unpack8(*gp, ga, gb);
            *gp = pack8(ga * (w0a * u0a + w1a * u1a + w2a * u2a), gb * (w0b * u0b + w1b * u1b + w2b * u2b));
        }
        for (int it = gt; it < M_TOK * 32; it += NGT) {
            const int row = it >> 5, c8 = (it & 31) * 8;
            const float* pr = (row < MP) ? p_p + (size_t)row * DPLE + c8 : p_s + (size_t)(row - MP) * DPLE + c8;
            *(u32x4*)(PB + (size_t)row * DPLE + c8) = pack8(*(const f32x4*)pr, *(const f32x4*)(pr + 4));
        }
    }

#define LOAD_TILE2(dst, X, un_) do { const int c_ = (un_) >> 3, h_ = (un_) & 7; _Pragma("unroll") for (int i_ = 0; i_ < 2; ++i_) { const int p_ = tid + 512 * i_; \
        dst[i_] = *(const u32x4*)((X) + ((size_t)c_ * 64 + (p_ >> 4)) * DM + h_ * 128 + (p_ & 15) * 8); } } while (0)
#define LOAD_TILE2_NT(dst, X, un_) do { const int c_ = (un_) >> 3, h_ = (un_) & 7; _Pragma("unroll") for (int i_ = 0; i_ < 2; ++i_) { const int p_ = tid + 512 * i_; \
        dst[i_] = __builtin_nontemporal_load((const u32x4*)((X) + ((size_t)c_ * 64 + (p_ >> 4)) * DM + h_ * 128 + (p_ & 15) * 8)); } } while (0)
#define SCATTER_VT(vt_, w_, s_, vg_) do { LAS unsigned short* d_ = (vt_) + ((vg_) * 8) * 72 + VT_GRP((vg_) * 8, (s_) >> 3) + ((s_) & 7); \
        d_[0 * 72] = (unsigned short)((w_).x & 0xffff); d_[1 * 72] = (unsigned short)((w_).x >> 16); d_[2 * 72] = (unsigned short)((w_).y & 0xffff); d_[3 * 72] = (unsigned short)((w_).y >> 16); \
        d_[4 * 72] = (unsigned short)((w_).z & 0xffff); d_[5 * 72] = (unsigned short)((w_).z >> 16); d_[6 * 72] = (unsigned short)((w_).w & 0xffff); d_[7 * 72] = (unsigned short)((w_).w >> 16); } while (0)
    {
        LAS unsigned short* LFb = (LAS unsigned short*)lds;
        LAS unsigned short* kdb = (LAS unsigned short*)(lds + 34816);
        LAS unsigned short* vTb = (LAS unsigned short*)(lds + 71680);
        LAS float* decb = (LAS float*)(lds + 126976);
        const int nsu = (bid < NSU) ? (NSU - bid + G - 1) / G : 0, nps = NSC * nsu;
        const int nst = nps + ((bid < NSMP) ? (NSMP - bid + G - 1) / G : 0);
        u32x4 plf[2], pv[2];
        f32x16 acc0, acc1; float dprod = 1.f;
#pragma unroll
        for (int i = 0; i < 16; ++i) { acc0[i] = 0.f; acc1[i] = 0.f; }
#define P2B_LOAD(j_) do { int un_, su_; bool f_, l_; step_map((j_), nps, bid, G, un_, su_, f_, l_); LOAD_TILE2(plf, LFH, un_); LOAD_TILE2(pv, V, un_); } while (0)
#define P2B_STAGE(j_) do { LAS unsigned short* LF_ = LFb + ((j_) & 1) * (64 * 136); LAS unsigned short* vT_ = vTb + ((j_) % 3) * (128 * 72); \
        _Pragma("unroll") for (int i = 0; i < 2; ++i) { const int p = tid + 512 * i, t = p >> 4, g8 = p & 15; *(LAS u32x4*)(LF_ + t * 136 + g8 * 8) = plf[i]; SCATTER_VT(vT_, pv[i], t, g8); } } while (0)
#define P2B_SCAN(j_) do { int un_, su_; bool f_, l_; step_map((j_), nps, bid, G, un_, su_, f_, l_); \
        p2b_scan(LFb + ((j_) & 1) * (64 * 136), kdb + ((j_) & 1) * (128 * 72), decb + ((j_) & 1) * 128, su_ >= 0 ? DEC + (size_t)su_ * 128 : nullptr, f_, l_, dprod, tid); } while (0)
        if (nst > 0) {
            P2B_LOAD(0); P2B_STAGE(0);
            if (nst > 1) P2B_LOAD(1);
            __syncthreads();
            P2B_SCAN(0);
            if (nst > 1) P2B_STAGE(1);
            if (nst > 2) P2B_LOAD(2);
            __syncthreads();
            for (int j = 0; j < nst; ++j) {
                if (j + 2 < nst) P2B_STAGE(j + 2);
                if (j + 3 < nst) P2B_LOAD(j + 3);
                { int un, su; bool first, last; step_map(j, nps, bid, G, un, su, first, last);
                  p2b_mfma(kdb + (j & 1) * (128 * 72), vTb + (j % 3) * (128 * 72), decb + (j & 1) * 128, un, su, first, last, acc0, acc1, DST, st_hgrn, out + O_HS, wave, lane); }
                if (j + 1 < nst) P2B_SCAN(j + 1);
                __syncthreads();
            }
        }
    }
    GSYNC();

    {
        constexpr int NSQ = NCHUNK_P / NSC / 4;
        for (int it = gt; it < 32 * 4096; it += NGT) {
            const int bh = it >> 12, g4 = it & 4095, b = bh >> 3, h = bh & 7;
            const int v = ((g4 >> 8) & 3) * 32 + (g4 & 31), k0 = (g4 >> 10) * 32 + 8 * ((g4 >> 6) & 3) + 4 * ((g4 >> 5) & 1);
            float S0 = 0.f, S1 = 0.f, S2 = 0.f, S3 = 0.f;
            for (int c0 = 0; c0 < NSQ; c0 += 8) {
                u32x2 ds[8]; f32x4 dc[8];
#pragma unroll
                for (int j = 0; j < 8; ++j) { const size_t su = ((size_t)(b * NSQ + c0 + j)) * 8 + h; ds[j] = *(const u32x2*)(DST + su * 16384 + g4 * 4); dc[j] = *(const f32x4*)(DEC + su * 128 + k0); }
#pragma unroll
                for (int j = 0; j < 8; ++j) { const size_t su = ((size_t)(b * NSQ + c0 + j)) * 8 + h;
                    u32x2 w; w.x = cvt_pk_bf16(S0, S1); w.y = cvt_pk_bf16(S2, S3);
                    *(u32x2*)(DST + su * 16384 + g4 * 4) = w;
                    S0 = dc[j][0] * S0 + bflo(ds[j].x); S1 = dc[j][1] * S1 + bfhi(ds[j].x); S2 = dc[j][2] * S2 + bflo(ds[j].y); S3 = dc[j][3] * S3 + bfhi(ds[j].y); }
            }
            float* so = out + O_HP + (size_t)bh * 16384;
            so[(k0 + 0) * 128 + v] = S0; so[(k0 + 1) * 128 + v] = S1; so[(k0 + 2) * 128 + v] = S2; so[(k0 + 3) * 128 + v] = S3;
        }
    }
    GSYNC();

    {
        LAS unsigned short* LF = (LAS unsigned short*)lds;
        LAS unsigned short* QS = (LAS unsigned short*)(lds + 17408);
        LAS unsigned short* vT = (LAS unsigned short*)(lds + 34816);
        LAS unsigned short* qe = (LAS unsigned short*)(lds + 53248);
        LAS unsigned short* ke = (LAS unsigned short*)(lds + 70656);
        LAS unsigned short* qb = (LAS unsigned short*)(lds + 88064);
        LAS unsigned short* kd = (LAS unsigned short*)(lds + 105472);
        LAS unsigned short* ost = (LAS unsigned short*)(lds + 123904);
        LAS float* qsum = (LAS float*)(lds + 141312);
        LAS float* decs = (LAS float*)(lds + 143360);
        const int nsu = (bid < NSU) ? (NSU - bid + G - 1) / G : 0, nps = NSC * nsu;
        const int nst = nps + ((bid < NSMP) ? (NSMP - bid + G - 1) / G : 0);
        const int tb = wave & 1, vb = wave >> 1, r = lane & 31, hh = lane >> 5;
        u32x4 plf[2], pq[2], pv[2];
        u32x4 sfr[8];
#pragma unroll
        for (int i = 0; i < 8; ++i) sfr[i] = (u32x4){0u, 0u, 0u, 0u};
        if (nst > 0) { int un_, su_; bool f_, l_; step_map(0, nps, bid, G, un_, su_, f_, l_); LOAD_TILE2_NT(plf, LFH, un_); LOAD_TILE2_NT(pq, Q, un_); LOAD_TILE2_NT(pv, V, un_); }
        for (int j = 0; j < nst; ++j) {
            int un, su; bool first, last; step_map(j, nps, bid, G, un, su, first, last);
            const int cidx = un >> 3, h = un & 7; const size_t row0 = (size_t)cidx * 64;
#pragma unroll
            for (int i = 0; i < 2; ++i) { const int p = tid + 512 * i, t = p >> 4, g8 = p & 15;
                *(LAS u32x4*)(LF + t * 136 + g8 * 8) = plf[i]; *(LAS u32x4*)(QS + t * 136 + g8 * 8) = pq[i]; SCATTER_VT(vT, pv[i], t, g8); }
            if (first) {
                if (su >= 0) {
                    const bf16_t* sp = DST + (size_t)su * 16384 + vb * 1024 + launder(lane) * 4;
#pragma unroll
                    for (int kt = 0; kt < 4; ++kt)
#pragma unroll
                        for (int s2 = 0; s2 < 2; ++s2) { const u32x2 lo = *(const u32x2*)(sp + kt * 4096 + (2 * s2) * 256), hi = *(const u32x2*)(sp + kt * 4096 + (2 * s2 + 1) * 256);
                            sfr[kt * 2 + s2] = (u32x4){lo.x, lo.y, hi.x, hi.y}; }
                } else {
                    const float* s0 = st_hgrn + ((size_t)(cidx - NCHUNK_P) * 8 + h) * 16384 + vb * 32 + r;
#pragma unroll
                    for (int f8 = 0; f8 < 8; ++f8) { float sv[8];
#pragma unroll
                        for (int e = 0; e < 8; ++e) sv[e] = s0[(size_t)(16 * f8 + 8 * (e >> 2) + 4 * hh + (e & 3)) * 128];
                        sfr[f8] = (u32x4){cvt_pk_bf16(sv[0], sv[1]), cvt_pk_bf16(sv[2], sv[3]), cvt_pk_bf16(sv[4], sv[5]), cvt_pk_bf16(sv[6], sv[7])}; }
                }
            }
            __syncthreads();
            if (j + 1 < nst) { int un_, su_; bool f_, l_; step_map(j + 1, nps, bid, G, un_, su_, f_, l_); LOAD_TILE2_NT(plf, LFH, un_); LOAD_TILE2_NT(pq, Q, un_); LOAD_TILE2_NT(pv, V, un_); }
            {
                const int k = tid & 127, tq = tid >> 7;
                float fv[16]; float sprod = 1.0f;
#pragma unroll
                for (int jj = 0; jj < 16; ++jj) { fv[jj] = h2f(LF[(tq * 16 + jj) * 136 + k]); sprod *= fv[jj]; }
                qsum[tq * 128 + k] = sprod;
                __syncthreads();
                const float s0q = qsum[k], s1q = qsum[128 + k], s2q = qsum[256 + k], s3q = qsum[384 + k];
                const float eref = s0q * s1q, etot = s2q * s3q, ptot = eref * etot;
                float kv[16];
                float e1 = ((tq > 0 ? s0q : 1.0f) * (tq > 1 ? s1q : 1.0f) * (tq > 2 ? s2q : 1.0f)) * __builtin_amdgcn_rcpf(eref);
#pragma unroll
                for (int jj = 0; jj < 16; ++jj) { const int t = tq * 16 + jj;
                    const float q = silu_f(bf2f(QS[t * 136 + k])) * QK_SCALE;
                    const float fj = fv[jj]; const float kk = 1.0f - fj;
                    e1 *= fj;
                    const float qev = q * e1, kev = kk * __builtin_amdgcn_rcpf(e1);
                    kv[jj] = kev * etot;
                    qe[t * 136 + k] = f2bf(qev); ke[t * 136 + k] = f2bf(kev); qb[t * 136 + k] = f2bf(qev * eref); }
                u32x4 w0, w1;
                w0.x = cvt_pk_bf16(kv[0], kv[1]); w0.y = cvt_pk_bf16(kv[2], kv[3]); w0.z = cvt_pk_bf16(kv[4], kv[5]); w0.w = cvt_pk_bf16(kv[6], kv[7]);
                w1.x = cvt_pk_bf16(kv[8], kv[9]); w1.y = cvt_pk_bf16(kv[10], kv[11]); w1.z = cvt_pk_bf16(kv[12], kv[13]); w1.w = cvt_pk_bf16(kv[14], kv[15]);
                *(LAS u32x4*)(kd + k * 72 + tq * 16) = w0; *(LAS u32x4*)(kd + k * 72 + tq * 16 + 8) = w1;
                if (tq == 0) decs[k] = ptot;
            }
            __syncthreads();
            f32x16 oacc;
#pragma unroll
            for (int i = 0; i < 16; ++i) oacc[i] = 0.f;
            {
                const LAS unsigned short* qrow = qb + (tb * 32 + r) * 136 + 4 * hh;
#pragma unroll
                for (int kt = 0; kt < 4; ++kt)
#pragma unroll
                    for (int s2 = 0; s2 < 2; ++s2) {
                        const bf16x8 bfr = __builtin_bit_cast(bf16x8, sfr[kt * 2 + s2]);
                        const s16x4 lo = *(const LAS s16x4*)(qrow + 32 * kt + 16 * s2), hi = *(const LAS s16x4*)(qrow + 32 * kt + 16 * s2 + 8);
                        const bf16x8 af = __builtin_shufflevector(lo, hi, 0, 1, 2, 3, 4, 5, 6, 7);
                        oacc = __builtin_amdgcn_mfma_f32_32x32x16_bf16(af, bfr, oacc, 0, 0, 0);
                        if (s2 == 1) __builtin_amdgcn_sched_barrier(0);
                    }
            }
            __builtin_amdgcn_sched_barrier(0);
            const int vrow = vb * 32 + r;
            for (int sb = 0; sb <= tb; ++sb) {
                f32x16 att;
#pragma unroll
                for (int i = 0; i < 16; ++i) att[i] = 0.f;
#pragma unroll
                for (int ks = 0; ks < 8; ++ks) {
                    const bf16x8 af = *(const LAS bf16x8*)(ke + (sb * 32 + r) * 136 + 16 * ks + 8 * hh);
                    const bf16x8 bfr = *(const LAS bf16x8*)(qe + (tb * 32 + r) * 136 + 16 * ks + 8 * hh);
                    att = __builtin_amdgcn_mfma_f32_32x32x16_bf16(af, bfr, att, 0, 0, 0);
                    if (ks & 1) __builtin_amdgcn_sched_barrier(0);
                }
                if (sb == tb) {
#pragma unroll
                    for (int i = 0; i < 16; ++i) { const int sl = (i & 3) + 8 * (i >> 2) + 4 * hh; if (sl > r) att[i] = 0.f; }
                }
#pragma unroll
                for (int s2 = 0; s2 < 2; ++s2) {
                    u32x4 w; w.x = cvt_pk_bf16(att[8 * s2 + 0], att[8 * s2 + 1]); w.y = cvt_pk_bf16(att[8 * s2 + 2], att[8 * s2 + 3]);
                    w.z = cvt_pk_bf16(att[8 * s2 + 4], att[8 * s2 + 5]); w.w = cvt_pk_bf16(att[8 * s2 + 6], att[8 * s2 + 7]);
                    const bf16x8 af = __builtin_bit_cast(bf16x8, w);
                    const LAS unsigned short* vp = vT + vrow * 72 + 4 * hh;
                    const s16x4 lo = *(const LAS s16x4*)(vp + VT_GRP(vrow, sb * 4 + 2 * s2)), hi = *(const LAS s16x4*)(vp + VT_GRP(vrow, sb * 4 + 2 * s2 + 1));
                    const bf16x8 bfr = __builtin_shufflevector(lo, hi, 0, 1, 2, 3, 4, 5, 6, 7);
                    oacc = __builtin_amdgcn_mfma_f32_32x32x16_bf16(af, bfr, oacc, 0, 0, 0);
                }
            }
#pragma unroll
            for (int i = 0; i < 16; ++i) ost[(tb * 32 + (i & 3) + 8 * (i >> 2) + 4 * hh) * 136 + vb * 32 + r] = f2bf(oacc[i]);
            __builtin_amdgcn_sched_barrier(0);
            if (!last) {
#pragma unroll
                for (int kt = 0; kt < 4; ++kt) {
                    f32x16 d;
#pragma unroll
                    for (int s2 = 0; s2 < 2; ++s2) { const u32x4 w = sfr[kt * 2 + s2];
                        d[8 * s2 + 0] = bflo(w.x); d[8 * s2 + 1] = bfhi(w.x); d[8 * s2 + 2] = bflo(w.y); d[8 * s2 + 3] = bfhi(w.y);
                        d[8 * s2 + 4] = bflo(w.z); d[8 * s2 + 5] = bfhi(w.z); d[8 * s2 + 6] = bflo(w.w); d[8 * s2 + 7] = bfhi(w.w); }
#pragma unroll
                    for (int i = 0; i < 16; ++i) d[i] *= decs[kt * 32 + (i & 3) + 8 * (i >> 2) + 4 * hh];
#pragma unroll
                    for (int ks = 0; ks < 4; ++ks) {
                        const bf16x8 af = *(const LAS bf16x8*)(kd + (kt * 32 + r) * 72 + 16 * ks + 8 * hh);
                        const bf16x8 bfr = *(const LAS bf16x8*)(vT + vrow * 72 + VT_GRP(vrow, 2 * ks + hh));
                        d = __builtin_amdgcn_mfma_f32_32x32x16_bf16(af, bfr, d, 0, 0, 0);
                    }
#pragma unroll
                    for (int s2 = 0; s2 < 2; ++s2)
                        sfr[kt * 2 + s2] = (u32x4){cvt_pk_bf16(d[8 * s2 + 0], d[8 * s2 + 1]), cvt_pk_bf16(d[8 * s2 + 2], d[8 * s2 + 3]), cvt_pk_bf16(d[8 * s2 + 4], d[8 * s2 + 5]), cvt_pk_bf16(d[8 * s2 + 6], d[8 * s2 + 7])};
                    __builtin_amdgcn_sched_barrier(0);
                }
            }
            u32x4 psz[2];
            LOAD_TILE2_NT(psz, SZ, un);
            __syncthreads();
#pragma unroll
            for (int i = 0; i < 2; ++i) { const int p = tid + 512 * i, t = p >> 4, vg = p & 15;
                f32x4 o0, o1, z0, z1; unpack8(*(const LAS u32x4*)(ost + t * 136 + vg * 8), o0, o1);
                float ss = (o0[0] * o0[0] + o0[1] * o0[1]) + (o0[2] * o0[2] + o0[3] * o0[3]) + (o1[0] * o1[0] + o1[1] * o1[1]) + (o1[2] * o1[2] + o1[3] * o1[3]);
                ss += __shfl_xor(ss, 1); ss += __shfl_xor(ss, 2); ss += __shfl_xor(ss, 4); ss += __shfl_xor(ss, 8);
                const float rs = rsqrtf(ss * (1.0f / 128.0f) + EPS);
                unpack8(psz[i], z0, z1);
#pragma unroll
                for (int e = 0; e < 4; ++e) { z0[e] = silu_f(z0[e]); z1[e] = silu_f(z1[e]); }
                *(u32x4*)(SZ + (row0 + t) * DM + h * 128 + vg * 8) = pack8(o0 * rs * z0, o1 * rs * z1);
                __builtin_amdgcn_sched_barrier(0); }
        }
        __syncthreads();
    }
    GSYNC();

    {
        { pg8::Gemm g{GA, SZ, BTAB, MP, DM, 2048, DM, 2048, 16}; pg8::StaticOrder S; S.init(MP, DM, G, bid);
          EpiMerge E{SGA, SGB, MG};
          pg8::gemm_phase<EpiMerge, true, true>(lds, g, S, E); }
        { pg8::Gemm gp{PB, nullptr, BTP, MP, DM, DPLE, DPLE, DPLE, 0}; pg8::StaticOrder S2; S2.init(MP, DM, G, bid);
          EpiPP E2{PP}; pg8::gemm_phase<EpiPP, true, true>(lds, gp, S2, E2); }
        for (int tile = bid; tile < 256; tile += G) {
            const int tr = tile >> 3, tc = tile & 7, rbase = MP + tr * 64, cbase = tc * 128;
            const int wr2 = wave >> 2, wc4 = wave & 3, r = lane & 31, hh = lane >> 5;
            const int col = cbase + wc4 * 32 + r;
            {
                f32x16 accP;
#pragma unroll
                for (int i = 0; i < 16; ++i) accP[i] = 0.f;
                accP = mini_gemm(lds, PB + (size_t)rbase * DPLE, DPLE, BTP + (size_t)cbase * DPLE, DPLE, DPLE, tid, wave, lane, accP);
#pragma unroll
                for (int i = 0; i < 16; ++i) { const int row = rbase + wr2 * 32 + (i & 3) + 8 * (i >> 2) + 4 * hh; PP[(size_t)row * DM + col] = f2bf(accP[i]); }
            }
            f32x16 accA, accB;
#pragma unroll
            for (int i = 0; i < 16; ++i) { accA[i] = 0.f; accB[i] = 0.f; }
            accA = mini_gemm(lds, GA + (size_t)rbase * DM, DM, BTAB + (size_t)cbase * 2048, 2048, DM, tid, wave, lane, accA);
            accB = mini_gemm(lds, SZ + (size_t)rbase * DM, DM, BTAB + (size_t)cbase * 2048 + 1024, 2048, DM, tid, wave, lane, accB);
            float ga[16], gb[16];
#pragma unroll
            for (int i = 0; i < 16; ++i) { const int row = rbase + wr2 * 32 + (i & 3) + 8 * (i >> 2) + 4 * hh; const size_t off = (size_t)row * DM + col;
                ga[i] = bf2f(SGA[off]); gb[i] = bf2f(SGB[off]); }
#pragma unroll
            for (int i = 0; i < 16; ++i) { const int row = rbase + wr2 * 32 + (i & 3) + 8 * (i >> 2) + 4 * hh; const size_t off = (size_t)row * DM + col;
                MG[off] = f2bf(ga[i] * accA[i] + gb[i] * accB[i]); }
        }
    }
    GSYNC();

    {
        { pg8::Gemm g{MG, nullptr, BTO, MP, DM, DM, DM, DM, 0}; pg8::StaticOrder S; S.init(MP, DM, G, bid);
          EpiO E{OUTB, SSQ};
          pg8::gemm_phase<EpiO, true, true>(lds, g, S, E); }
        for (int tile = bid; tile < 256; tile += G) {
            const int tr = tile >> 3, tc = tile & 7, rbase = MP + tr * 64, cbase = tc * 128;
            const int wr2 = wave >> 2, wc4 = wave & 3, r = lane & 31, hh = lane >> 5;
            const int col = cbase + wc4 * 32 + r;
            f32x16 acc;
#pragma unroll
            for (int i = 0; i < 16; ++i) acc[i] = 0.f;
            acc = mini_gemm(lds, MG + (size_t)rbase * DM, DM, BTO + (size_t)cbase * DM, DM, DM, tid, wave, lane, acc);
#pragma unroll
            for (int i = 0; i < 16; ++i) { const int row = rbase + wr2 * 32 + (i & 3) + 8 * (i >> 2) + 4 * hh;
                OUTB[(size_t)row * DM + col] = f2bf(acc[i]);
                float s = acc[i] * acc[i];
                s += __shfl_xor(s, 1); s += __shfl_xor(s, 2); s += __shfl_xor(s, 4); s += __shfl_xor(s, 8); s += __shfl_xor(s, 16);
                if (r == 0) SSQ2[(size_t)(row - MP) * 32 + tc * 4 + wc4] = s; }
        }
    }
    GSYNC();

    {
        const f32x4* gr = (const f32x4*)g_post + lane;
        f32x4 gp[4];
#pragma unroll
        for (int j = 0; j < 4; ++j) gp[j] = gr[64 * j];
        for (int m0 = gw; m0 < M_TOK; m0 += 2 * NGW) {
            const int m1 = m0 + NGW; const bool has1 = m1 < M_TOK; const int m1c = has1 ? m1 : m0;
            const f32x4* xr0 = (const f32x4*)((m0 < MP) ? x_p + (size_t)m0 * DM : x_s + (size_t)(m0 - MP) * DM) + lane;
            const f32x4* xr1 = (const f32x4*)((m1c < MP) ? x_p + (size_t)m1c * DM : x_s + (size_t)(m1c - MP) * DM) + lane;
            const u32x2* or0 = (const u32x2*)(OUTB + (size_t)m0 * DM) + lane; const u32x2* or1 = (const u32x2*)(OUTB + (size_t)m1c * DM) + lane;
            float sq0 = (m0 < MP) ? ((lane < 16) ? SSQ[(size_t)m0 * 16 + lane] : 0.f) : ((lane < 32) ? SSQ2[(size_t)(m0 - MP) * 32 + lane] : 0.f);
            float sq1 = (m1c < MP) ? ((lane < 16) ? SSQ[(size_t)m1c * 16 + lane] : 0.f) : ((lane < 32) ? SSQ2[(size_t)(m1c - MP) * 32 + lane] : 0.f);
            f32x4 x0[4], x1[4]; u32x2 w0[4], w1[4];
#pragma unroll
            for (int j = 0; j < 4; ++j) { x0[j] = xr0[64 * j]; x1[j] = xr1[64 * j]; w0[j] = or0[64 * j]; w1[j] = or1[64 * j]; }
            sq0 = wave_sum(sq0); sq1 = wave_sum(sq1);
            const float rs0 = rsqrtf(sq0 * (1.0f / DM) + EPS), rs1 = rsqrtf(sq1 * (1.0f / DM) + EPS);
            float s0 = 0.f, s1 = 0.f;
#pragma unroll
            for (int j = 0; j < 4; ++j) {
                const f32x4 of0 = (f32x4){bflo(w0[j].x), bfhi(w0[j].x), bflo(w0[j].y), bfhi(w0[j].y)}, of1 = (f32x4){bflo(w1[j].x), bfhi(w1[j].x), bflo(w1[j].y), bfhi(w1[j].y)};
                x0[j] = x0[j] + of0 * rs0 * gp[j]; x1[j] = x1[j] + of1 * rs1 * gp[j];
                s0 += (x0[j][0] * x0[j][0] + x0[j][1] * x0[j][1]) + (x0[j][2] * x0[j][2] + x0[j][3] * x0[j][3]);
                s1 += (x1[j][0] * x1[j][0] + x1[j][1] * x1[j][1]) + (x1[j][2] * x1[j][2] + x1[j][3] * x1[j][3]); }
            s0 = wave_sum(s0); s1 = wave_sum(s1);
            if (lane == 0) { R1[m0] = rsqrtf(s0 * (1.0f / DM) + EPS); RINV[m0] = rs0; if (has1) { R1[m1] = rsqrtf(s1 * (1.0f / DM) + EPS); RINV[m1] = rs1; } }
            f32x4* y0 = (f32x4*)(out + O_Y + (size_t)m0 * DM) + lane; u32x2* b0 = (u32x2*)(X1B + (size_t)m0 * DM) + lane;
#pragma unroll
            for (int j = 0; j < 4; ++j) { if (m0 >= MP) y0[64 * j] = x0[j];
                u32x2 w; w.x = cvt_pk_bf16(x0[j][0], x0[j][1]); w.y = cvt_pk_bf16(x0[j][2], x0[j][3]); b0[64 * j] = w; }
            if (has1) {
                f32x4* y1 = (f32x4*)(out + O_Y + (size_t)m1 * DM) + lane; u32x2* b1 = (u32x2*)(X1B + (size_t)m1 * DM) + lane;
#pragma unroll
                for (int j = 0; j < 4; ++j) { if (m1 >= MP) y1[64 * j] = x1[j];
                    u32x2 w; w.x = cvt_pk_bf16(x1[j][0], x1[j][1]); w.y = cvt_pk_bf16(x1[j][2], x1[j][3]); b1[64 * j] = w; }
            }
        }
    }
    GSYNC();

    {
        pg8::StaticOrder S; S.init(M_TOK, DM, G, bid);
        { pg8::Gemm g{X1B, nullptr, BTG, MP, DM, DM, DM, DM, 0}; pg8::StaticOrder Sp; Sp.init(MP, DM, G, bid); EpiFinal E{R1, RINV  , PP, OUTB, x_p, g_post, out + O_Y}; pg8::gemm_phase<EpiFinal, true, true>(lds, g, Sp, E); }
        for (int tile = bid; tile < 256; tile += G) {
            const int tr = tile >> 3, tc = tile & 7, rbase = MP + tr * 64, cbase = tc * 128;
            f32x16 acc;
#pragma unroll
            for (int i = 0; i < 16; ++i) acc[i] = 0.f;
            acc = mini_gemm(lds, X1B + (size_t)rbase * DM, DM, BTG + (size_t)cbase * DM, DM, DM, tid, wave, lane, acc);
            const int wr2 = wave >> 2, wc4 = wave & 3, r = lane & 31, hh = lane >> 5;
            const int col = cbase + wc4 * 32 + r;
            float yv[16], pv2[16], rv[16];
#pragma unroll
            for (int i = 0; i < 16; ++i) { const int row = rbase + wr2 * 32 + (i & 3) + 8 * (i >> 2) + 4 * hh; const size_t off = (size_t)row * DM + col;
                yv[i] = out[O_Y + off]; pv2[i] = bf2f(PP[off]); rv[i] = R1[row]; }
#pragma unroll
            for (int i = 0; i < 16; ++i) { const int row = rbase + wr2 * 32 + (i & 3) + 8 * (i >> 2) + 4 * hh; const size_t off = (size_t)row * DM + col;
                out[O_Y + off] = yv[i] + pv2[i] * sigmoid_f(acc[i] * rv[i]); }
        }
    }
}

extern "C" void kernel_launch(void* const* d_in, const int* in_sizes, int n_in, void* d_out, int out_size, void* d_ws, size_t ws_size, hipStream_t stream) {
    static int grid_blocks = 0;
    if (grid_blocks == 0) {
        if (n_in != 18 || (size_t)out_size != O_TOTAL || ws_size < WS_END) { fprintf(stderr, "kernel_launch: unexpected shapes (n_in %d out %d ws %zu)\n", n_in, out_size, ws_size); grid_blocks = -1; return; }
        int dev = 0, cus = 0, per_cu = 0;
        hipGetDevice(&dev);
        hipDeviceGetAttribute(&cus, hipDeviceAttributeMultiprocessorCount, dev);
        hipFuncSetAttribute((const void*)fwd_kernel, hipFuncAttributeMaxDynamicSharedMemorySize, LDS_BYTES);
        hipOccupancyMaxActiveBlocksPerMultiprocessor(&per_cu, (const void*)fwd_kernel, 512, LDS_BYTES);
        if (per_cu < 1) { fprintf(stderr, "kernel_launch: occupancy query says %d blocks per CU\n", per_cu); grid_blocks = -1; return; }
        grid_blocks = cus * per_cu;
    }
    if (grid_blocks < 0) return;
    if (hipMemsetAsync((char*)d_ws + WS_BAR, 0, XCD_BAR_WORDS * 4, stream) != hipSuccess) { fprintf(stderr, "kernel_launch: memset of barrier words failed\n"); return; }
    Args a{};
    for (int i = 0; i < 18; ++i) a.in[i] = (const float*)d_in[i];
    a.out = (float*)d_out; a.ws = (unsigned char*)d_ws;
    void* args[] = {&a};
    hipError_t e = hipLaunchCooperativeKernel((const void*)fwd_kernel, dim3(grid_blocks), dim3(512), args, LDS_BYTES, stream);
    if (e != hipSuccess) fprintf(stderr, "cooperative launch failed: %s (grid %d)\n", hipGetErrorString(e), grid_blocks);
}
```

```cpp
#include <hip/hip_runtime.h>
#include <cstdio>
#include <cstdint>
#include <cstddef>

#define LAS __attribute__((address_space(3)))
typedef unsigned short bf16_t;
typedef short bf16x8 __attribute__((ext_vector_type(8)));
typedef short s16x4 __attribute__((ext_vector_type(4)));
typedef float f32x4 __attribute__((ext_vector_type(4)));
typedef float f32x16 __attribute__((ext_vector_type(16)));
typedef unsigned u32x4 __attribute__((ext_vector_type(4)));
typedef unsigned u32x2 __attribute__((ext_vector_type(2)));

constexpr int M_TOK = 34816;
constexpr int MP = 32768;
constexpr int DM = 1024;
constexpr int NIN = 10240;
constexpr int DPLE = 256;
constexpr float EPS = 1e-6f;
constexpr float QK_SCALE = 0.08838834764831845f;
constexpr int NCHUNK = M_TOK / 64;
constexpr int NCHUNK_P = MP / 64;

typedef float f32x2_t __attribute__((ext_vector_type(2))); typedef __bf16 bf16x2_t __attribute__((ext_vector_type(2)));
__device__ __forceinline__ unsigned cvt_pk_bf16(float lo, float hi) { f32x2_t v = {lo, hi}; bf16x2_t b = __builtin_convertvector(v, bf16x2_t); return __builtin_bit_cast(unsigned, b); }
__device__ __forceinline__ float bf2f(unsigned short b) { return __uint_as_float((unsigned)b << 16); }
__device__ __forceinline__ float bflo(unsigned w) { return __uint_as_float(w << 16); }
__device__ __forceinline__ float bfhi(unsigned w) { return __uint_as_float(w & 0xffff0000u); }
__device__ __forceinline__ unsigned short f2bf(float f) { return (unsigned short)(cvt_pk_bf16(f, 0.0f) & 0xffffu); }
__device__ __forceinline__ float sigmoid_f(float x) { return __builtin_amdgcn_rcpf(1.0f + __expf(-x)); }
__device__ __forceinline__ float silu_f(float x) { return x * sigmoid_f(x); }
__device__ __forceinline__ unsigned short f2h(float f) { _Float16 h = (_Float16)f; return __builtin_bit_cast(unsigned short, h); }
__device__ __forceinline__ float h2f(unsigned short u) { return (float)__builtin_bit_cast(_Float16, u); }
__device__ __forceinline__ float wave_sum(float v) {
#pragma unroll
    for (int o = 1; o < 64; o <<= 1) v += __shfl_xor(v, o);
    return v;
}
#define LDS_WAIT() asm volatile("s_waitcnt lgkmcnt(0)" ::: "memory")
__device__ __forceinline__ int launder(int x) { asm volatile("" : "+v"(x)); return x; }

namespace pg8 {
constexpr int BM = 256, BK = 64, HALF = 128, HTB = HALF * BK * 2, STAGE_BYTES = 8 * HTB, NXCD = 8, WGM = 8;
__host__ __device__ __forceinline__ int lds_byte(int r, int c) { const int st = (r >> 4) * 2 + (c >> 5), rr = r & 15, cc = c & 31, ob = rr * 64 + cc * 2; return st * 1024 + (ob ^ (((ob >> 9) & 1) << 5)); }
__host__ __device__ __forceinline__ void stage_rc(int b, int& R, int& C) { const int st = b / 1024, sb = b % 1024, swz = sb ^ (((sb >> 9) & 1) << 5); R = (st >> 1) * 16 + swz / 64; C = (st & 1) * 32 + (swz % 64) / 2; }
__host__ __device__ __forceinline__ int perm32(int rho) { const int n = rho >> 4, i = rho & 15; return 8 * (i >> 2) + 4 * n + (i & 3); }

struct Unit { int pm, pn; };
struct Gemm { const bf16_t* A; const bf16_t* A2; const bf16_t* Bt; int M, N, K, lda, ldb, kseg; };

struct StaticOrder {
    int nM, nN, nwg, G, c;
    __host__ __device__ void init(int M, int N, int G_, int c_) { nM = M / BM; nN = N / BM; nwg = nM * nN; G = G_; c = c_; }
    __host__ __device__ bool next(int i, Unit& u) const {
        const long L = (long)i * G + c; if (L >= nwg) return false;
        int wgid = (int)L; { const int q = nwg / NXCD, r = nwg % NXCD, xcd = wgid % NXCD, off = wgid / NXCD; wgid = (xcd < r ? xcd * (q + 1) : r * (q + 1) + (xcd - r) * q) + off; }
        const int nig = WGM * nN, gid = wgid / nig, fm = gid * WGM, gsz = (nM - fm) < WGM ? (nM - fm) : WGM;
        u.pm = fm + ((wgid % nig) % gsz); u.pn = (wgid % nig) / gsz; return true;
    }
};

template <class Epi, bool ALIGN_EPI, bool SP2>
__device__ __forceinline__ void gemm_phase(LAS unsigned char* lds, const Gemm g, const StaticOrder& S, const Epi& E) {
    const int tid = launder((int)threadIdx.x), wid = __builtin_amdgcn_readfirstlane(tid >> 6), lane = tid & 63, wr = wid >> 2, wc = wid & 3, fr = lane & 15, fq = lane >> 4;
    const int K = g.K, nt = K / BK;
    unsigned voffA[2], voffB[2];
#pragma unroll
    for (int i = 0; i < 2; ++i) { int R, C; stage_rc(tid * 16 + i * 8192, R, C); const int Rb = (R & ~31) + perm32(R & 31);
        voffA[i] = (unsigned)(R * g.lda + C) * 2u; voffB[i] = (unsigned)(Rb * g.ldb + C) * 2u; }
    const size_t kstep = (size_t)(BK * 2);
    const size_t hstepA = (size_t)HALF * g.lda * 2, hstepB = (size_t)HALF * g.ldb * 2;
    const size_t tstepA = 2 * hstepA, tstepB = 2 * hstepB;
    const ptrdiff_t segd = g.A2 ? (((const char*)g.A2 - (const char*)g.A) - (ptrdiff_t)g.kseg * (ptrdiff_t)kstep) : (ptrdiff_t)0;
    const int kseg = g.A2 ? g.kseg : (nt + 8);
    const unsigned ldsw = (unsigned)wid * 1024u;
    const int aoff = lds_byte(wr * 64 + fr, fq * 8), boff = lds_byte(wc * 32 + fr, fq * 8);
#define PG8_SA(b, h) (((b) * 2 + (h)) * HTB)
#define PG8_SB(b, h) ((4 + (b) * 2 + (h)) * HTB)
#define PG8_STAGE(bufoff, gbase, voff) do { _Pragma("unroll") for (int _i = 0; _i < 2; ++_i) \
        __builtin_amdgcn_global_load_lds((const unsigned*)((const char*)(gbase) + (voff)[_i]), (LAS unsigned*)(lds + (bufoff) + ldsw + _i * 8192), 16, 0, 0); } while (0)
#define PG8_LDA(dst, b, h) do { _Pragma("unroll") for (int m = 0; m < 4; ++m) _Pragma("unroll") for (int k = 0; k < 2; ++k) dst[m][k] = *(const LAS bf16x8*)(lds + PG8_SA(b, h) + aoff + m * 2048 + k * 1024); } while (0)
#define PG8_LDB(dst, b, h) do { _Pragma("unroll") for (int n = 0; n < 2; ++n) _Pragma("unroll") for (int k = 0; k < 2; ++k) dst[n][k] = *(const LAS bf16x8*)(lds + PG8_SB(b, h) + boff + n * 2048 + k * 1024); } while (0)
#define PG8_MMA(ai, bj, At, Bt) do { __builtin_amdgcn_s_setprio(1); _Pragma("unroll") for (int m = 0; m < 4; ++m) _Pragma("unroll") for (int n = 0; n < 2; ++n) _Pragma("unroll") for (int k = 0; k < 2; ++k) \
        acc[ai][bj][m][n] = __builtin_amdgcn_mfma_f32_16x16x32_bf16(Bt[n][k], At[m][k], acc[ai][bj][m][n], 0, 0, 0); __builtin_amdgcn_s_setprio(0); } while (0)
#define PG8_WAIT_V(n) asm volatile("s_waitcnt vmcnt(" #n ")" ::: "memory")
#define PG8_WAIT_L(n) asm volatile("s_waitcnt lgkmcnt(" #n ")" ::: "memory")
#define PG8_BAR __builtin_amdgcn_s_barrier()
#define PG8_SCHED __builtin_amdgcn_sched_barrier(0)
    Unit cur, nxt; int ui = 0;
    if (!S.next(0, cur)) return;
    f32x4 acc[2][2][4][2];
#pragma unroll
    for (int a = 0; a < 2; ++a)
#pragma unroll
        for (int b = 0; b < 2; ++b)
#pragma unroll
            for (int m = 0; m < 4; ++m)
#pragma unroll
                for (int n = 0; n < 2; ++n) acc[a][b][m][n] = (f32x4){0.f, 0.f, 0.f, 0.f};
    bf16x8 At[4][2], B0[2][2], B1[2][2];
    const char* cA = (const char*)g.A + (size_t)cur.pm * tstepA; const char* cB = (const char*)g.Bt + (size_t)cur.pn * tstepB;
    if constexpr (SP2) {
        PG8_STAGE(PG8_SB(0, 0), cB, voffB); PG8_STAGE(PG8_SB(0, 1), cB + hstepB, voffB); PG8_STAGE(PG8_SA(0, 0), cA, voffA); PG8_STAGE(PG8_SA(0, 1), cA + hstepA, voffA);
        if (wr == 1) PG8_BAR;
        PG8_WAIT_V(2); PG8_BAR;
        PG8_STAGE(PG8_SB(1, 0), cB + kstep, voffB); PG8_STAGE(PG8_SA(1, 0), cA + kstep, voffA); PG8_STAGE(PG8_SB(1, 1), cB + hstepB + kstep, voffB);
        PG8_WAIT_V(6); PG8_BAR;
    } else {
        PG8_STAGE(PG8_SB(0, 0), cB, voffB); PG8_STAGE(PG8_SA(0, 0), cA, voffA); PG8_STAGE(PG8_SB(0, 1), cB + hstepB, voffB); PG8_STAGE(PG8_SA(0, 1), cA + hstepA, voffA);
        if (wr == 1) PG8_BAR;
        PG8_WAIT_V(4); PG8_BAR;
        PG8_STAGE(PG8_SB(1, 0), cB + kstep, voffB); PG8_STAGE(PG8_SA(1, 0), cA + kstep, voffA); PG8_STAGE(PG8_SB(1, 1), cB + hstepB + kstep, voffB);
        PG8_WAIT_V(6); PG8_BAR;
    }
    for (;;) {
        const bool has_next = S.next(ui + 1, nxt);
        const char* nA = has_next ? (const char*)g.A + (size_t)nxt.pm * tstepA : cA; const char* nB = has_next ? (const char*)g.Bt + (size_t)nxt.pn * tstepB : cB;
#pragma nounroll
        for (int t = 0; t < nt; t += 2) {
            if constexpr (Epi::HAS_MID) { if (t == kseg) E.mid(acc, cur, wr, wc, fr, fq); }
            const bool last = (t == nt - 2);
            const char* a1 = cA + (size_t)(t + 1) * kstep + ((t + 1) >= kseg ? segd : (ptrdiff_t)0);
            const char* a2 = last ? nA : cA + (size_t)(t + 2) * kstep + ((t + 2) >= kseg ? segd : (ptrdiff_t)0);
            const char* b2 = last ? nB : cB + (size_t)(t + 2) * kstep;
            const char* a3 = a2 + kstep; const char* b3 = b2 + kstep;
            if constexpr (SP2) {
            PG8_LDB(B0, 0, 0); PG8_LDB(B1, 0, 1); PG8_SCHED; PG8_LDA(At, 0, 0); PG8_STAGE(PG8_SA(1, 1), a1 + hstepA, voffA);
            PG8_WAIT_V(8); PG8_WAIT_L(0); PG8_BAR; PG8_MMA(0, 0, At, B0); PG8_MMA(0, 1, At, B1); PG8_BAR; PG8_SCHED;
            PG8_LDA(At, 0, 1); PG8_STAGE(PG8_SB(0, 0), b2, voffB); PG8_STAGE(PG8_SB(0, 1), b2 + hstepB, voffB); PG8_STAGE(PG8_SA(0, 0), a2, voffA);
            PG8_WAIT_V(8); PG8_WAIT_L(0); PG8_BAR; PG8_MMA(1, 0, At, B0); PG8_MMA(1, 1, At, B1); PG8_BAR; PG8_SCHED;
            PG8_LDB(B0, 1, 0); PG8_LDB(B1, 1, 1); PG8_SCHED; PG8_LDA(At, 1, 0); PG8_STAGE(PG8_SA(0, 1), a2 + hstepA, voffA);
            PG8_WAIT_V(8); PG8_WAIT_L(0); PG8_BAR; PG8_MMA(0, 0, At, B0); PG8_MMA(0, 1, At, B1); PG8_BAR; PG8_SCHED;
            PG8_LDA(At, 1, 1); PG8_STAGE(PG8_SB(1, 0), b3, voffB); PG8_STAGE(PG8_SB(1, 1), b3 + hstepB, voffB); PG8_STAGE(PG8_SA(1, 0), a3, voffA);
            PG8_WAIT_V(8); PG8_WAIT_L(0); PG8_BAR; PG8_MMA(1, 0, At, B0); PG8_MMA(1, 1, At, B1); PG8_BAR; PG8_SCHED;
            } else {
            PG8_LDB(B0, 0, 0); PG8_SCHED; PG8_LDA(At, 0, 0); PG8_STAGE(PG8_SA(1, 1), a1 + hstepA, voffA);
            PG8_WAIT_L(8); PG8_BAR; PG8_WAIT_L(0); PG8_MMA(0, 0, At, B0); PG8_BAR; PG8_SCHED;
            PG8_LDB(B1, 0, 1); PG8_STAGE(PG8_SB(0, 0), b2, voffB);
            PG8_BAR; PG8_WAIT_L(0); PG8_MMA(0, 1, At, B1); PG8_BAR;
            PG8_LDA(At, 0, 1); PG8_STAGE(PG8_SA(0, 0), a2, voffA);
            PG8_BAR; PG8_WAIT_L(0); PG8_MMA(1, 0, At, B0); PG8_BAR; PG8_SCHED;
            PG8_STAGE(PG8_SB(0, 1), b2 + hstepB, voffB);
            PG8_WAIT_V(6); PG8_BAR; PG8_MMA(1, 1, At, B1); PG8_BAR;
            PG8_LDB(B0, 1, 0); PG8_SCHED; PG8_LDA(At, 1, 0); PG8_STAGE(PG8_SA(0, 1), a2 + hstepA, voffA);
            PG8_WAIT_L(8); PG8_BAR; PG8_WAIT_L(0); PG8_MMA(0, 0, At, B0); PG8_BAR; PG8_SCHED;
            PG8_LDB(B1, 1, 1); PG8_STAGE(PG8_SB(1, 0), b3, voffB);
            PG8_BAR; PG8_WAIT_L(0); PG8_MMA(0, 1, At, B1); PG8_BAR;
            PG8_LDA(At, 1, 1); PG8_STAGE(PG8_SA(1, 0), a3, voffA);
            PG8_BAR; PG8_WAIT_L(0); PG8_MMA(1, 0, At, B0); PG8_BAR; PG8_SCHED;
            PG8_STAGE(PG8_SB(1, 1), b3 + hstepB, voffB);
            PG8_WAIT_V(6); PG8_BAR; PG8_MMA(1, 1, At, B1); PG8_BAR;
            }
        }
        if constexpr (ALIGN_EPI) { if (wr == 0) PG8_BAR; }
        E(acc, cur, wr, wc, fr, fq);
        if (!has_next) break;
#pragma unroll
        for (int a = 0; a < 2; ++a)
#pragma unroll
            for (int b = 0; b < 2; ++b)
#pragma unroll
                for (int m = 0; m < 4; ++m)
#pragma unroll
                    for (int n = 0; n < 2; ++n) acc[a][b][m][n] = (f32x4){0.f, 0.f, 0.f, 0.f};
        cur = nxt; cA = nA; cB = nB; ++ui;
        if constexpr (ALIGN_EPI) { if (wr == 1) PG8_BAR; }
    }
    PG8_WAIT_V(0);
    if constexpr (!ALIGN_EPI) { if (wr == 0) PG8_BAR; }
    PG8_BAR;
#undef PG8_SA
#undef PG8_SB
#undef PG8_STAGE
#undef PG8_LDA
#undef PG8_LDB
#undef PG8_MMA
#undef PG8_WAIT_V
#undef PG8_WAIT_L
#undef PG8_BAR
#undef PG8_SCHED
}
}

__device__ __forceinline__ u32x4 pack8(const f32x4 a, const f32x4 b) { u32x4 w; w.x = cvt_pk_bf16(a[0], a[1]); w.y = cvt_pk_bf16(a[2], a[3]); w.z = cvt_pk_bf16(b[0], b[1]); w.w = cvt_pk_bf16(b[2], b[3]); return w; }
__device__ __forceinline__ void unpack8(const u32x4 w, f32x4& a, f32x4& b) { a = (f32x4){bflo(w.x), bfhi(w.x), bflo(w.y), bfhi(w.y)}; b = (f32x4){bflo(w.z), bfhi(w.z), bflo(w.w), bfhi(w.w)}; }

struct Epi1 {
    static constexpr bool HAS_MID = false;
    const float* rinv; const float* lbv;
    bf16_t *UF, *GA, *Q, *V, *SZ, *SGA, *SGB; unsigned short* LFH; float* conv_p; float* conv_s; const float* convw; LAS unsigned char* ldsx;
    __device__ __forceinline__ void operator()(const f32x4 (&acc)[2][2][4][2], const pg8::Unit& u, int wr, int wc, int fr, int fq) const {
        const int row0 = launder(u.pm * 256 + wr * 64 + fr);
        float rv[2][4];
#pragma unroll
        for (int ai = 0; ai < 2; ++ai)
#pragma unroll
            for (int m = 0; m < 4; ++m) rv[ai][m] = rinv[row0 + ai * 128 + m * 16];
        if (u.pn < 16) {
            const int c4 = launder(u.pn * 64 + wc * 16 + 4 * fq);
            const f32x4 w0 = *(const f32x4*)(convw + c4), w1 = *(const f32x4*)(convw + DM + c4), w2 = *(const f32x4*)(convw + 2 * DM + c4);
            LAS unsigned short* wl = (LAS unsigned short*)(ldsx + (wr * 4 + wc) * 2048);
#pragma unroll
            for (int ai = 0; ai < 2; ++ai) {
                f32x4 uu[4], gg[4];
#pragma unroll
                for (int m = 0; m < 4; ++m) {
                    const int row = row0 + ai * 128 + m * 16; const float r = rv[ai][m]; const float r2 = r * r;
                    uu[m] = acc[ai][0][m][0] * acc[ai][0][m][1] * r2;
#pragma unroll
                    for (int e = 0; e < 4; ++e) gg[m][e] = silu_f(acc[ai][1][m][1][e] * r) * (acc[ai][1][m][0][e] * r);
                    float* cdst = nullptr;
                    if (row < MP) { const int t = row & 8191; if (t >= 8190) cdst = conv_p + ((size_t)((row >> 13) * 2 + (t - 8190))) * DM + c4; }
                    else { const int rs = row - MP; const int t = rs & 63; if (t >= 62) cdst = conv_s + ((size_t)((rs >> 6) * 2 + (t - 62))) * DM + c4; }
                    if (cdst) *(f32x4*)cdst = uu[m];
                    u32x2 w; w.x = cvt_pk_bf16(uu[m][0], uu[m][1]); w.y = cvt_pk_bf16(uu[m][2], uu[m][3]);
                    *(LAS u32x2*)(wl + (16 * m + fr) * 16 + 4 * fq) = w;
                    if ((m == 0 && fr < 2) || (m == 3 && fr >= 14)) { const int slot = (m == 0) ? fr : (fr - 12);
                        *(u32x2*)(UF + ((size_t)(row >> 6) * 4 + slot) * DM + c4) = w; }
                }
                LDS_WAIT(); asm volatile("" ::: "memory");
#pragma unroll
                for (int m = 0; m < 4; ++m) {
                    const int row = row0 + ai * 128 + m * 16; const int lr = 16 * m + fr;
                    f32x4 res = gg[m];
                    if (lr >= 2) {
                        const u32x2 a1 = *(const LAS u32x2*)(wl + (lr - 1) * 16 + 4 * fq), a2 = *(const LAS u32x2*)(wl + (lr - 2) * 16 + 4 * fq);
                        const f32x4 um1 = (f32x4){bflo(a1.x), bfhi(a1.x), bflo(a1.y), bfhi(a1.y)}, um2 = (f32x4){bflo(a2.x), bfhi(a2.x), bflo(a2.y), bfhi(a2.y)};
                        res = gg[m] * (w0 * um2 + w1 * um1 + w2 * uu[m]);
                    }
                    u32x2 w; w.x = cvt_pk_bf16(res[0], res[1]); w.y = cvt_pk_bf16(res[2], res[3]);
                    *(u32x2*)(GA + (size_t)row * DM + c4) = w;
                }
                LDS_WAIT(); asm volatile("" ::: "memory");
            }
            return;
        }
        const int type = 2 + ((u.pn - 16) >> 3);
        const int ch0 = launder(((u.pn - 16) & 7) * 128 + wc * 32 + 8 * fq);
        if (type == 2) {
            const f32x4 lb0 = *(const f32x4*)(lbv + ch0), lb1 = *(const f32x4*)(lbv + ch0 + 4);
#pragma unroll
            for (int ai = 0; ai < 2; ++ai)
#pragma unroll
                for (int m = 0; m < 4; ++m) {
                    const int row = row0 + ai * 128 + m * 16; const float r = rv[ai][m];
                    f32x4 q0, q1; unsigned short lf[8];
#pragma unroll
                    for (int i = 0; i < 4; ++i) {
                        q0[i] = acc[ai][0][m][0][i] * r; q1[i] = acc[ai][0][m][1][i] * r;
                        const float f0 = lb0[i] + (1.0f - lb0[i]) * sigmoid_f(acc[ai][1][m][0][i] * r), f1 = lb1[i] + (1.0f - lb1[i]) * sigmoid_f(acc[ai][1][m][1][i] * r);
                        lf[i] = f2h(f0); lf[4 + i] = f2h(f1);
                    }
                    *(u32x4*)(Q + (size_t)row * DM + ch0) = pack8(q0, q1);
                    u32x4 w; w.x = (unsigned)lf[0] | ((unsigned)lf[1] << 16); w.y = (unsigned)lf[2] | ((unsigned)lf[3] << 16); w.z = (unsigned)lf[4] | ((unsigned)lf[5] << 16); w.w = (unsigned)lf[6] | ((unsigned)lf[7] << 16);
                    *(u32x4*)(LFH + (size_t)row * DM + ch0) = w;
                }
        } else if (type == 3) {
#pragma unroll
            for (int ai = 0; ai < 2; ++ai)
#pragma unroll
                for (int m = 0; m < 4; ++m) {
                    const int row = row0 + ai * 128 + m * 16; const float r = rv[ai][m];
                    f32x4 z0, z1;
#pragma unroll
                    for (int i = 0; i < 4; ++i) { z0[i] = acc[ai][1][m][0][i] * r; z1[i] = acc[ai][1][m][1][i] * r; }
                    *(u32x4*)(V + (size_t)row * DM + ch0) = pack8(acc[ai][0][m][0] * r, acc[ai][0][m][1] * r);
                    *(u32x4*)(SZ + (size_t)row * DM + ch0) = pack8(z0, z1);
                }
        } else {
#pragma unroll
            for (int ai = 0; ai < 2; ++ai)
#pragma unroll
                for (int m = 0; m < 4; ++m) {
                    const int row = row0 + ai * 128 + m * 16; const float r = rv[ai][m];
                    f32x4 a0, a1, b0, b1;
#pragma unroll
                    for (int i = 0; i < 4; ++i) { a0[i] = sigmoid_f(acc[ai][0][m][0][i] * r); a1[i] = sigmoid_f(acc[ai][0][m][1][i] * r); b0[i] = sigmoid_f(acc[ai][1][m][0][i] * r); b1[i] = sigmoid_f(acc[ai][1][m][1][i] * r); }
                    *(u32x4*)(SGA + (size_t)row * DM + ch0) = pack8(a0, a1);
                    *(u32x4*)(SGB + (size_t)row * DM + ch0) = pack8(b0, b1);
                }
        }
    }
};

struct EpiMerge {
    static constexpr bool HAS_MID = true;
    const bf16_t *SGA, *SGB; bf16_t* MG;
    __device__ __forceinline__ void mid(f32x4 (&acc)[2][2][4][2], const pg8::Unit& u, int wr, int wc, int fr, int fq) const {
        const int row0 = launder(u.pm * 256 + wr * 64 + fr), colb = launder(u.pn * 256 + wc * 32 + 8 * fq);
#pragma unroll
        for (int ai = 0; ai < 2; ++ai) {
            u32x4 la[4][2], lb[4][2];
#pragma unroll
            for (int m = 0; m < 4; ++m)
#pragma unroll
                for (int bj = 0; bj < 2; ++bj) { const size_t off = (size_t)(row0 + ai * 128 + m * 16) * DM + colb + bj * 128;
                    la[m][bj] = __builtin_nontemporal_load((const u32x4*)(SGA + off)); lb[m][bj] = *(const u32x4*)(SGB + off); }
#pragma unroll
            for (int m = 0; m < 4; ++m)
#pragma unroll
                for (int bj = 0; bj < 2; ++bj) {
                    f32x4 a0, a1, b0, b1; unpack8(la[m][bj], a0, a1); unpack8(lb[m][bj], b0, b1);
#pragma unroll
                    for (int i = 0; i < 4; ++i) { acc[ai][bj][m][0][i] *= a0[i] * __builtin_amdgcn_rcpf(b0[i]); acc[ai][bj][m][1][i] *= a1[i] * __builtin_amdgcn_rcpf(b1[i]); }
                }
            asm volatile("" : "+v"(acc[ai][0][0][0]), "+v"(acc[ai][1][3][1]) :: "memory");
        }
    }
    __device__ __forceinline__ void operator()(const f32x4 (&acc)[2][2][4][2], const pg8::Unit& u, int wr, int wc, int fr, int fq) const {
        const int row0 = launder(u.pm * 256 + wr * 64 + fr), colb = launder(u.pn * 256 + wc * 32 + 8 * fq);
#pragma unroll
        for (int ai = 0; ai < 2; ++ai) {
            u32x4 lb[4][2];
#pragma unroll
            for (int m = 0; m < 4; ++m)
#pragma unroll
                for (int bj = 0; bj < 2; ++bj) lb[m][bj] = __builtin_nontemporal_load((const u32x4*)(SGB + (size_t)(row0 + ai * 128 + m * 16) * DM + colb + bj * 128));
#pragma unroll
            for (int m = 0; m < 4; ++m)
#pragma unroll
                for (int bj = 0; bj < 2; ++bj) { const size_t off = (size_t)(row0 + ai * 128 + m * 16) * DM + colb + bj * 128;
                    f32x4 b0, b1; unpack8(lb[m][bj], b0, b1);
                    *(u32x4*)(MG + off) = pack8(acc[ai][bj][m][0] * b0, acc[ai][bj][m][1] * b1); }
            asm volatile("" ::: "memory");
        }
    }
};

struct EpiO {
    static constexpr bool HAS_MID = false;
    bf16_t* OUT; float* SSQ;
    __device__ __forceinline__ void operator()(const f32x4 (&acc)[2][2][4][2], const pg8::Unit& u, int wr, int wc, int fr, int fq) const {
        const int row0 = launder(u.pm * 256 + wr * 64 + fr), colb = launder(u.pn * 256 + wc * 32 + 8 * fq);
#pragma unroll
        for (int ai = 0; ai < 2; ++ai)
#pragma unroll
            for (int m = 0; m < 4; ++m) {
                const int row = row0 + ai * 128 + m * 16; float s = 0.f;
#pragma unroll
                for (int bj = 0; bj < 2; ++bj) {
                    const f32x4 v0 = acc[ai][bj][m][0], v1 = acc[ai][bj][m][1];
                    *(u32x4*)(OUT + (size_t)row * DM + colb + bj * 128) = pack8(v0, v1);
                    s += (v0[0] * v0[0] + v0[1] * v0[1]) + (v0[2] * v0[2] + v0[3] * v0[3]) + (v1[0] * v1[0] + v1[1] * v1[1]) + (v1[2] * v1[2] + v1[3] * v1[3]);
                }
                s += __shfl_xor(s, 16); s += __shfl_xor(s, 32);
                if (fq == 0) SSQ[(size_t)row * 16 + u.pn * 4 + wc] = s;
            }
    }
};

struct EpiPP {
    static constexpr bool HAS_MID = false;
    bf16_t* PP;
    __device__ __forceinline__ void operator()(const f32x4 (&acc)[2][2][4][2], const pg8::Unit& u, int wr, int wc, int fr, int fq) const {
        const int row0 = launder(u.pm * 256 + wr * 64 + fr), colb = launder(u.pn * 256 + wc * 32 + 8 * fq);
#pragma unroll
        for (int ai = 0; ai < 2; ++ai)
#pragma unroll
            for (int m = 0; m < 4; ++m)
#pragma unroll
                for (int bj = 0; bj < 2; ++bj) {
                    const size_t off = (size_t)(row0 + ai * 128 + m * 16) * DM + colb + bj * 128;
                    *(u32x4*)(PP + off) = pack8(acc[ai][bj][m][0], acc[ai][bj][m][1]);
                }
    }
};

struct EpiFinal {
    static constexpr bool HAS_MID = false;
    const float* R1; const float* RS; const bf16_t* PP; const bf16_t* OUT; const float* X; const float* gpost; float* Y;
    __device__ __forceinline__ void operator()(const f32x4 (&acc)[2][2][4][2], const pg8::Unit& u, int wr, int wc, int fr, int fq) const {
        const int row0 = launder(u.pm * 256 + wr * 64 + fr), colb = launder(u.pn * 256 + wc * 32 + 8 * fq);
        f32x4 g[2][2];
#pragma unroll
        for (int bj = 0; bj < 2; ++bj) { g[bj][0] = *(const f32x4*)(gpost + colb + bj * 128); g[bj][1] = *(const f32x4*)(gpost + colb + bj * 128 + 4); }
#pragma unroll
        for (int ai = 0; ai < 2; ++ai)
#pragma unroll
            for (int mp = 0; mp < 2; ++mp) {
                u32x4 lp[2][2], lo[2][2]; f32x4 lx[2][2][2]; float rr[2], rsv[2];
#pragma unroll
                for (int mm = 0; mm < 2; ++mm) { const int row = row0 + ai * 128 + (2 * mp + mm) * 16; rr[mm] = R1[row]; rsv[mm] = RS[row];
#pragma unroll
                    for (int bj = 0; bj < 2; ++bj) { const size_t off = (size_t)row * DM + colb + bj * 128;
                        lp[mm][bj] = __builtin_nontemporal_load((const u32x4*)(PP + off)); lo[mm][bj] = __builtin_nontemporal_load((const u32x4*)(OUT + off));
                        lx[mm][bj][0] = __builtin_nontemporal_load((const f32x4*)(X + off)); lx[mm][bj][1] = __builtin_nontemporal_load((const f32x4*)(X + off + 4)); } }
#pragma unroll
                for (int mm = 0; mm < 2; ++mm) { const int m = 2 * mp + mm; const int row = row0 + ai * 128 + m * 16; const float r = rr[mm], rs = rsv[mm];
#pragma unroll
                    for (int bj = 0; bj < 2; ++bj) { const size_t off = (size_t)row * DM + colb + bj * 128;
                        f32x4 p0, p1, o0, o1; unpack8(lp[mm][bj], p0, p1); unpack8(lo[mm][bj], o0, o1);
                        f32x4 y0 = lx[mm][bj][0] + o0 * rs * g[bj][0], y1 = lx[mm][bj][1] + o1 * rs * g[bj][1];
#pragma unroll
                        for (int i = 0; i < 4; ++i) { y0[i] += p0[i] * sigmoid_f(acc[ai][bj][m][0][i] * r); y1[i] += p1[i] * sigmoid_f(acc[ai][bj][m][1][i] * r); }
                        __builtin_nontemporal_store(y0, (f32x4*)(Y + off)); __builtin_nontemporal_store(y1, (f32x4*)(Y + off + 4)); } }
                asm volatile("" ::: "memory");
            }
    }
};

constexpr size_t MiB = 1u << 20;
constexpr size_t BUF = (size_t)M_TOK * DM * 2;
constexpr size_t WS_GA = 0, WS_Q = 68 * MiB, WS_LFH = 136 * MiB, WS_V = 204 * MiB, WS_SZ = 272 * MiB, WS_U = 340 * MiB, WS_XB = 408 * MiB, WS_BTIN = 476 * MiB;
constexpr size_t WS_BTAB = 496 * MiB, WS_BTO = 500 * MiB, WS_BTG = 502 * MiB, WS_BTP = 504 * MiB;
constexpr size_t WS_RINV = 505 * MiB, WS_R1 = WS_RINV + 256 * 1024, WS_LBV = WS_R1 + 256 * 1024, WS_DEC = 506 * MiB, WS_SSQ = 509 * MiB, WS_END = 512 * MiB;
constexpr size_t WS_SSQ2 = WS_DEC + 1 * MiB;
constexpr size_t WS_BAR = 511 * MiB + 512 * 1024;
constexpr size_t WS_DST = WS_U;
constexpr size_t WS_MG = WS_U;
constexpr size_t WS_OUT = WS_Q;
constexpr size_t WS_X1B = WS_V;
constexpr size_t WS_PB = WS_BTIN;
constexpr size_t WS_PP = WS_XB;
static_assert(BUF == 68 * MiB, "buffer size");
static_assert(WS_DEC + (size_t)NCHUNK * 8 * 128 * 4 <= WS_SSQ && WS_SSQ + (size_t)M_TOK * 16 * 4 <= WS_END, "ws map");
constexpr size_t O_Y = 0, O_CONVP = (size_t)M_TOK * DM, O_HP = O_CONVP + 4 * 2 * 1024, O_CONVS = O_HP + (size_t)4 * 8 * 128 * 128, O_HS = O_CONVS + 32 * 2 * 1024;
constexpr size_t O_TOTAL = O_HS + (size_t)32 * 8 * 128 * 128;

struct Args { const float* in[18]; float* out; unsigned char* ws; };

__device__ __forceinline__ void p0_transpose(const float* W, int N, const float* scale, bf16_t* dst, int ldk, int koff, int dstrow0, int k0, int n0, LAS float* scr, int lane, bool amap = false) {
    float wv[32], sv[32];
#pragma unroll
    for (int i = 0; i < 32; ++i) { const int kk = 2 * i + (lane >> 5); wv[i] = __builtin_nontemporal_load(W + (size_t)(k0 + kk) * N + n0 + (lane & 31)); sv[i] = scale ? scale[k0 + kk] : 1.0f; }
#pragma unroll
    for (int i = 0; i < 32; ++i) { const int kk = 2 * i + (lane >> 5); scr[kk * 33 + (lane & 31)] = wv[i] * sv[i]; }
    LDS_WAIT(); asm volatile("" ::: "memory");
    const int c = lane & 7;
#pragma unroll
    for (int j = 0; j < 4; ++j) { const int n = (lane >> 3) + 8 * j; const LAS float* s = scr + (8 * c) * 33 + n;
        u32x4 o; o.x = cvt_pk_bf16(s[0 * 33], s[1 * 33]); o.y = cvt_pk_bf16(s[2 * 33], s[3 * 33]); o.z = cvt_pk_bf16(s[4 * 33], s[5 * 33]); o.w = cvt_pk_bf16(s[6 * 33], s[7 * 33]);
        const int nr = amap ? (32 * (n >> 4) + 8 * ((n >> 2) & 3) + (n & 3)) : n;
        *(u32x4*)(dst + (size_t)(dstrow0 + nr) * ldk + koff + k0 + 8 * c) = o; }
    LDS_WAIT(); asm volatile("" ::: "memory");
}

#define VT_GRP(v_, g_) ((((g_) ^ (((v_) >> 3) & 7)) << 3))
constexpr int NSC = 4;
constexpr int NSU = (NCHUNK_P / NSC) * 8;
constexpr int NSMP = (NCHUNK - NCHUNK_P) * 8;
__device__ __forceinline__ void step_map(int j, int nps, int bid, int G, int& un, int& su, bool& first, bool& last) {
    if (j < nps) { const int i = j / NSC, c = j % NSC; su = bid + G * i; un = (((su >> 3) * NSC + c) << 3) + (su & 7); first = (c == 0); last = (c == NSC - 1); }
    else { su = -1; un = NCHUNK_P * 8 + bid + G * (j - nps); first = true; last = true; }
}
__device__ __forceinline__ void p2b_scan(const LAS unsigned short* LF, LAS unsigned short* kd, LAS float* decs, float* decg, bool first, bool last, float& dprod, int tid) {
    const int k = tid & 127, tq = tid >> 7;
    float fv[16];
#pragma unroll
    for (int j = 0; j < 16; ++j) fv[j] = h2f(LF[(tq * 16 + j) * 136 + k]);
    float er = 1.0f;
    for (int q2 = tq + 1; q2 < 4; ++q2) {
#pragma unroll
        for (int j = 0; j < 16; ++j) er *= h2f(LF[(q2 * 16 + j) * 136 + k]);
    }
    float kv[16];
#pragma unroll
    for (int j = 15; j >= 0; --j) { kv[j] = (1.0f - fv[j]) * er; er *= fv[j]; }
    u32x4 w0, w1;
    w0.x = cvt_pk_bf16(kv[0], kv[1]); w0.y = cvt_pk_bf16(kv[2], kv[3]); w0.z = cvt_pk_bf16(kv[4], kv[5]); w0.w = cvt_pk_bf16(kv[6], kv[7]);
    w1.x = cvt_pk_bf16(kv[8], kv[9]); w1.y = cvt_pk_bf16(kv[10], kv[11]); w1.z = cvt_pk_bf16(kv[12], kv[13]); w1.w = cvt_pk_bf16(kv[14], kv[15]);
    *(LAS u32x4*)(kd + k * 72 + tq * 16) = w0; *(LAS u32x4*)(kd + k * 72 + tq * 16 + 8) = w1;
    if (tq == 0) { const float d = er; decs[k] = d; dprod = first ? d : dprod * d; if (last && decg) decg[k] = dprod; }
}
__device__ __forceinline__ void p2b_mfma(const LAS unsigned short* kd, const LAS unsigned short* vT, const LAS float* decs, int un, int su, bool first, bool last,
                                         f32x16& acc0, f32x16& acc1, bf16_t* DST, const float* st_hgrn, float* out_hs, int wave, int lane) {
    const int cidx = un >> 3, h = un & 7;
    const int kt = wave >> 1, vt0 = (wave & 1) * 2, r = lane & 31, hh = lane >> 5;
    const int v0 = vt0 * 32 + r, v1 = v0 + 32;
    if (first) {
#pragma unroll
        for (int i = 0; i < 16; ++i) { acc0[i] = 0.f; acc1[i] = 0.f; }
    } else {
#pragma unroll
        for (int i = 0; i < 16; ++i) { const float d = decs[kt * 32 + (i & 3) + 8 * (i >> 2) + 4 * hh]; acc0[i] *= d; acc1[i] *= d; }
    }
#pragma unroll
    for (int ks = 0; ks < 4; ++ks) {
        const bf16x8 af = *(const LAS bf16x8*)(kd + (kt * 32 + r) * 72 + 16 * ks + 8 * hh);
        const bf16x8 b0 = *(const LAS bf16x8*)(vT + v0 * 72 + VT_GRP(v0, 2 * ks + hh));
        const bf16x8 b1 = *(const LAS bf16x8*)(vT + v1 * 72 + VT_GRP(v1, 2 * ks + hh));
        acc0 = __builtin_amdgcn_mfma_f32_32x32x16_bf16(af, b0, acc0, 0, 0, 0);
        acc1 = __builtin_amdgcn_mfma_f32_32x32x16_bf16(af, b1, acc1, 0, 0, 0);
    }
    if (!last) return;
    if (su >= 0) {
        bf16_t* dp = DST + (size_t)su * 16384 + (kt * 4 + vt0) * 1024 + lane * 4;
#pragma unroll
        for (int q = 0; q < 4; ++q) {
            u32x2 w0, w1; w0.x = cvt_pk_bf16(acc0[4 * q], acc0[4 * q + 1]); w0.y = cvt_pk_bf16(acc0[4 * q + 2], acc0[4 * q + 3]);
            w1.x = cvt_pk_bf16(acc1[4 * q], acc1[4 * q + 1]); w1.y = cvt_pk_bf16(acc1[4 * q + 2], acc1[4 * q + 3]);
            *(u32x2*)(dp + q * 256) = w0; *(u32x2*)(dp + 1024 + q * 256) = w1; }
    } else {
        const size_t sbase = ((size_t)(cidx - NCHUNK_P) * 8 + h) * 16384;
        const float* s0 = st_hgrn + sbase; float* so = out_hs + sbase;
        float p0[16], p1[16];
#pragma unroll
        for (int i = 0; i < 16; ++i) { const int k = kt * 32 + (i & 3) + 8 * (i >> 2) + 4 * hh; p0[i] = s0[k * 128 + v0]; p1[i] = s0[k * 128 + v1]; }
#pragma unroll
        for (int i = 0; i < 16; ++i) { const int k = kt * 32 + (i & 3) + 8 * (i >> 2) + 4 * hh; const float d = decs[k];
            so[k * 128 + v0] = d * p0[i] + acc0[i]; so[k * 128 + v1] = d * p1[i] + acc1[i]; }
    }
}

__device__ __forceinline__ f32x16 mini_gemm(LAS unsigned char* lds, const bf16_t* A, int lda, const bf16_t* Bt, int ldb, int K, int tid, int wave, int lane, f32x16 acc) {
    LAS unsigned short* As0 = (LAS unsigned short*)lds;
    LAS unsigned short* Bs0 = (LAS unsigned short*)(lds + 2 * 9216);
    const int lr = tid >> 3, lp = (tid & 7) * 8;
    const bf16_t* ap = A + (size_t)lr * lda + lp;
    const bf16_t* bp0 = Bt + (size_t)lr * ldb + lp; const bf16_t* bp1 = Bt + (size_t)(lr + 64) * ldb + lp;
    const int nk = K / 64;
    u32x4 ra[4], rb0[4], rb1[4];
#pragma unroll
    for (int s = 0; s < 4; ++s) { ra[s] = *(const u32x4*)(ap + 64 * s); rb0[s] = *(const u32x4*)(bp0 + 64 * s); rb1[s] = *(const u32x4*)(bp1 + 64 * s); }
    *(LAS u32x4*)(As0 + lr * 72 + lp) = ra[0]; *(LAS u32x4*)(Bs0 + lr * 72 + lp) = rb0[0]; *(LAS u32x4*)(Bs0 + (lr + 64) * 72 + lp) = rb1[0];
    __syncthreads();
    const int wr2 = wave >> 2, wc4 = wave & 3, r = lane & 31, hh = lane >> 5;
    for (int kt0 = 0; kt0 < nk; kt0 += 4) {
#pragma unroll
        for (int u = 0; u < 4; ++u) {
            const int kt = kt0 + u;
            if (kt + 4 < nk) { const int ko = (kt + 4) * 64; ra[u] = *(const u32x4*)(ap + ko); rb0[u] = *(const u32x4*)(bp0 + ko); rb1[u] = *(const u32x4*)(bp1 + ko); }
            const LAS unsigned short* As = As0 + (u & 1) * (64 * 72); const LAS unsigned short* Bs = Bs0 + (u & 1) * (128 * 72);
#pragma unroll
            for (int ks = 0; ks < 4; ++ks) {
                const bf16x8 af = *(const LAS bf16x8*)(As + (wr2 * 32 + r) * 72 + 16 * ks + 8 * hh);
                const bf16x8 bfr = *(const LAS bf16x8*)(Bs + (wc4 * 32 + r) * 72 + 16 * ks + 8 * hh);
                acc = __builtin_amdgcn_mfma_f32_32x32x16_bf16(af, bfr, acc, 0, 0, 0);
            }
            if (kt + 1 < nk) {
                LAS unsigned short* An = As0 + ((u + 1) & 1) * (64 * 72); LAS unsigned short* Bn = Bs0 + ((u + 1) & 1) * (128 * 72);
                *(LAS u32x4*)(An + lr * 72 + lp) = ra[(u + 1) & 3]; *(LAS u32x4*)(Bn + lr * 72 + lp) = rb0[(u + 1) & 3]; *(LAS u32x4*)(Bn + (lr + 64) * 72 + lp) = rb1[(u + 1) & 3];
            }
            __syncthreads();
        }
    }
    return acc;
}

#define XB_TMO      128
#define XB_XCNT(j)  (256  + 64 * (j))
#define XB_XSUB(j)  (1280 + 64 * (j))
#define XB_XGEN(j)  (2304 + 64 * (j))
#define XB_TOP      3328
#define XB_TOPGEN   3392
#define XCD_BAR_WORDS 3456
#define XB_SPIN_CAP (1u << 18)
__device__ __forceinline__ unsigned xb_ld(unsigned* p)              { return __hip_atomic_load(p, __ATOMIC_RELAXED, __HIP_MEMORY_SCOPE_AGENT); }
__device__ __forceinline__ unsigned xb_add(unsigned* p, unsigned v) { return __hip_atomic_fetch_add(p, v, __ATOMIC_RELAXED, __HIP_MEMORY_SCOPE_AGENT); }
__device__ __forceinline__ unsigned xb_xcc_id() { return (unsigned)__builtin_amdgcn_s_getreg((3 << 11) | 20) & 0xFu; }
#define XB_SPIN(cond, bar) do { unsigned _sp = 0; while (cond) { __builtin_amdgcn_s_sleep(1); \
    if ((++_sp & 255u) == 0u) { if (xb_ld(&(bar)[XB_TMO])) break; if (_sp > XB_SPIN_CAP) { atomicAdd(&(bar)[XB_TMO], 1u); break; } } } } while (0)
struct XcdBarrier { unsigned* bar; unsigned x; volatile LAS unsigned* st; };
__device__ __forceinline__ XcdBarrier xcd_barrier_post(unsigned* bar, volatile LAS unsigned* st) {
    XcdBarrier b; b.bar = bar; b.x = xb_xcc_id(); b.st = st;
    if (threadIdx.x == 0) (void)xb_add(&bar[XB_XCNT(b.x)], 1u);
    return b;
}
__device__ __forceinline__ void xcd_barrier_complete(unsigned* bar, unsigned x, unsigned& nloc, unsigned& nx) {
    const unsigned G = gridDim.x * gridDim.y * gridDim.z;
    unsigned sum, cnt, mine, sp = 0u;
    for (;;) {
        sum = 0u; cnt = 0u; mine = 0u;
#pragma unroll
        for (unsigned j = 0; j < 16; ++j) { const unsigned c = xb_ld(&bar[XB_XCNT(j)]); sum += c; cnt += (c > 0u) ? 1u : 0u; mine = (j == x) ? c : mine; }
        if (sum == G) break;
        __builtin_amdgcn_s_sleep(1);
        if ((++sp & 255u) == 0u) { if (xb_ld(&bar[XB_TMO])) break; if (sp > XB_SPIN_CAP) { atomicAdd(&bar[XB_TMO], 1u); break; } }
    }
    nloc = mine > 0u ? mine : 1u; nx = cnt > 0u ? cnt : 1u;
}
__device__ __forceinline__ void xcd_barrier(const XcdBarrier& b) {
    asm volatile("s_waitcnt vmcnt(0)" ::: "memory");
    __syncthreads();
    if (threadIdx.x == 0) {
        unsigned* bar = b.bar;
        __builtin_amdgcn_s_waitcnt(0);
        unsigned nloc = b.st[0], nx = b.st[1];
        if (nloc == 0u) { xcd_barrier_complete(bar, b.x, nloc, nx); b.st[0] = nloc; b.st[1] = nx; }
        const unsigned old = xb_add(&bar[XB_XSUB(b.x)], 1u);
        const unsigned gen = old / nloc;
        if (old + 1u == (gen + 1u) * nloc) {
            __builtin_amdgcn_fence(__ATOMIC_RELEASE, "agent");
            asm volatile("s_waitcnt vmcnt(0)" ::: "memory");
            const unsigned og = xb_add(&bar[XB_TOP], 1u);
            const unsigned tg = og / nx;
            if (og + 1u == (tg + 1u) * nx) xb_add(&bar[XB_TOPGEN], 1u);
            else XB_SPIN(xb_ld(&bar[XB_TOPGEN]) == tg, bar);
            __builtin_amdgcn_fence(__ATOMIC_ACQUIRE, "agent");
            xb_add(&bar[XB_XGEN(b.x)], 1u);
            asm volatile("s_waitcnt vmcnt(0)" ::: "memory");
        } else {
            XB_SPIN(xb_ld(&bar[XB_XGEN(b.x)]) == gen, bar);
            __builtin_amdgcn_fence(__ATOMIC_ACQUIRE, "agent");
            asm volatile("s_waitcnt vmcnt(0)" ::: "memory");
        }
    }
    __syncthreads();
}
#define GSYNC() xcd_barrier(bar)

constexpr int LDS_BYTES = 148480;

__global__ void __launch_bounds__(512, 2) fwd_kernel(Args a) {
    extern __shared__ __attribute__((aligned(16))) unsigned char lds_raw[];
    LAS unsigned char* lds = (LAS unsigned char*)lds_raw;
    const int tid = threadIdx.x, lane = tid & 63, wave = __builtin_amdgcn_readfirstlane(tid >> 6);
    const int G = gridDim.x, bid = blockIdx.x;
    const int gw = bid * 8 + wave, NGW = G * 8;
    const int gt = bid * 512 + tid, NGT = G * 512;
    volatile LAS unsigned* stw = (volatile LAS unsigned*)(lds + LDS_BYTES - 16);
    if (tid < 4) stw[tid] = 0u;
    __syncthreads();
    const XcdBarrier bar = xcd_barrier_post((unsigned*)(a.ws + WS_BAR), stw);

    const float* x_p = a.in[0]; const float* x_s = a.in[1]; const float* st_conv = a.in[2]; const float* st_hgrn = a.in[3];
    const float* p_p = a.in[4]; const float* p_s = a.in[5]; const float* w_in = a.in[6]; const float* conv_w = a.in[7]; const float* lb_raw = a.in[8];
    const float* g_pre = a.in[9]; const float* g_onorm = a.in[10]; const float* w_a_out = a.in[11]; const float* w_b_out = a.in[12]; const float* w_o = a.in[13];
    const float* g_post = a.in[14]; const float* g_ple = a.in[15]; const float* w_ple_gate = a.in[16]; const float* w_ple_proj = a.in[17];
    unsigned char* ws = a.ws; float* out = a.out;
    bf16_t* GA = (bf16_t*)(ws + WS_GA); bf16_t* Q = (bf16_t*)(ws + WS_Q); unsigned short* LFH = (unsigned short*)(ws + WS_LFH); bf16_t* V = (bf16_t*)(ws + WS_V);
    bf16_t* SZ = (bf16_t*)(ws + WS_SZ); bf16_t* UF = (bf16_t*)(ws + WS_U + 40 * MiB);    bf16_t* XB = (bf16_t*)(ws + WS_XB);
    bf16_t* BTIN = (bf16_t*)(ws + WS_BTIN); bf16_t* BTAB = (bf16_t*)(ws + WS_BTAB); bf16_t* BTO = (bf16_t*)(ws + WS_BTO); bf16_t* BTG = (bf16_t*)(ws + WS_BTG); bf16_t* BTP = (bf16_t*)(ws + WS_BTP);
    float* RINV = (float*)(ws + WS_RINV); float* R1 = (float*)(ws + WS_R1); float* LBV = (float*)(ws + WS_LBV); float* DEC = (float*)(ws + WS_DEC); float* SSQ = (float*)(ws + WS_SSQ); float* SSQ2 = (float*)(ws + WS_SSQ2);
    bf16_t* DST = (bf16_t*)(ws + WS_DST); bf16_t* MG = (bf16_t*)(ws + WS_MG); bf16_t* OUTB = (bf16_t*)(ws + WS_OUT); bf16_t* X1B = (bf16_t*)(ws + WS_X1B);
    bf16_t* PB = (bf16_t*)(ws + WS_PB); bf16_t* PP = (bf16_t*)(ws + WS_PP);
    bf16_t* SGA = (bf16_t*)(out + O_Y); bf16_t* SGB = (bf16_t*)((unsigned char*)(out + O_Y) + BUF);

    {
        LAS float* scr = (LAS float*)(lds + wave * 16384);
        constexpr int I_IN = 16 * 320, I_SQ = 16 * 32, I_P = 4 * 32;
        constexpr int NITEMS = I_IN + 4 * I_SQ + I_P;
        for (int it = gw; it < NITEMS; it += NGW) {
            int r = it;
            if (r < I_IN) {
                const int kb = r / 320, nb = r % 320, n0 = nb * 32, seg = n0 >> 10, ch = n0 & 1023;
                if (seg < 4) {
                    const int kind = ((seg & 1) << 1) | (seg >> 1);
                    const int drowa = (ch >> 6) * 256 + 128 * (kind >> 1) + 32 * ((ch >> 4) & 3) + 4 * (kind & 1);
                    p0_transpose(w_in, NIN, g_pre, BTIN, DM, 0, drowa, kb * 64, n0, scr, lane, true); continue; }
                const int code = seg;
                const int drow = (((code >> 1) * 8 + (ch >> 7)) * 256) + (code & 1) * 128 + (ch & 127);
                p0_transpose(w_in, NIN, g_pre, BTIN, DM, 0, drow, kb * 64, n0, scr, lane); continue; }
            r -= I_IN;
            if (r < I_SQ) { p0_transpose(w_a_out, DM, nullptr, BTAB, 2048, 0, (r % 32) * 32, (r / 32) * 64, (r % 32) * 32, scr, lane); continue; } r -= I_SQ;
            if (r < I_SQ) { p0_transpose(w_b_out, DM, g_onorm, BTAB, 2048, 1024, (r % 32) * 32, (r / 32) * 64, (r % 32) * 32, scr, lane); continue; } r -= I_SQ;
            if (r < I_SQ) { p0_transpose(w_o, DM, nullptr, BTO, DM, 0, (r % 32) * 32, (r / 32) * 64, (r % 32) * 32, scr, lane); continue; } r -= I_SQ;
            if (r < I_SQ) { p0_transpose(w_ple_gate, DM, g_ple, BTG, DM, 0, (r % 32) * 32, (r / 32) * 64, (r % 32) * 32, scr, lane); continue; } r -= I_SQ;
            p0_transpose(w_ple_proj, DM, nullptr, BTP, DPLE, 0, (r % 32) * 32, (r / 32) * 64, (r % 32) * 32, scr, lane);
        }
        for (int m0 = gw; m0 < M_TOK; m0 += 2 * NGW) {
            const int m1 = m0 + NGW; const bool has1 = m1 < M_TOK; const int m1c = has1 ? m1 : m0;
            const f32x4* xr0 = (const f32x4*)((m0 < MP) ? x_p + (size_t)m0 * DM : x_s + (size_t)(m0 - MP) * DM) + lane;
            const f32x4* xr1 = (const f32x4*)((m1c < MP) ? x_p + (size_t)m1c * DM : x_s + (size_t)(m1c - MP) * DM) + lane;
            f32x4 v0[4], v1[4]; float s0 = 0.f, s1 = 0.f;
#pragma unroll
            for (int j = 0; j < 4; ++j) { v0[j] = __builtin_nontemporal_load(xr0 + 64 * j); v1[j] = __builtin_nontemporal_load(xr1 + 64 * j); }
#pragma unroll
            for (int j = 0; j < 4; ++j) { s0 += (v0[j][0] * v0[j][0] + v0[j][1] * v0[j][1]) + (v0[j][2] * v0[j][2] + v0[j][3] * v0[j][3]);
                                          s1 += (v1[j][0] * v1[j][0] + v1[j][1] * v1[j][1]) + (v1[j][2] * v1[j][2] + v1[j][3] * v1[j][3]); }
            s0 = wave_sum(s0); s1 = wave_sum(s1);
            if (lane == 0) { RINV[m0] = rsqrtf(s0 * (1.0f / DM) + EPS); if (has1) RINV[m1] = rsqrtf(s1 * (1.0f / DM) + EPS); }
            u32x2* o0 = (u32x2*)(XB + (size_t)m0 * DM) + lane; u32x2* o1 = (u32x2*)(XB + (size_t)m1c * DM) + lane;
#pragma unroll
            for (int j = 0; j < 4; ++j) { u32x2 w; w.x = cvt_pk_bf16(v0[j][0], v0[j][1]); w.y = cvt_pk_bf16(v0[j][2], v0[j][3]); o0[64 * j] = w; }
            if (has1) {
#pragma unroll
                for (int j = 0; j < 4; ++j) { u32x2 w; w.x = cvt_pk_bf16(v1[j][0], v1[j][1]); w.y = cvt_pk_bf16(v1[j][2], v1[j][3]); o1[64 * j] = w; }
            }
        }
        if (bid == 0) for (int j = tid; j < 1024; j += 512) { const float e0 = __expf(lb_raw[j]), e1 = __expf(lb_raw[1024 + j]); LBV[j] = e0 / (e0 + e1); }
    }
    GSYNC();

    {
        pg8::Gemm g{XB, nullptr, BTIN, M_TOK, NIN, DM, DM, DM, 0}; pg8::StaticOrder S; S.init(M_TOK, NIN, G, bid);
        Epi1 E{RINV, LBV, UF, GA, Q, V, SZ, SGA, SGB, LFH, out + O_CONVP, out + O_CONVS, conv_w, lds + 131072};
        pg8::gemm_phase<Epi1, true, true>(lds, g, S, E);
    }
    GSYNC();

    {
        for (int it = gt; it < (M_TOK / 64) * 2 * 128; it += NGT) {
            const int c8 = (it & 127) * 8, t = (it >> 7) & 1, blk = it >> 8; const int row = blk * 64 + t;
            const bool seq0 = (blk >= NCHUNK_P) || ((blk & 127) == 0);
            f32x4 u2a, u2b, u1a, u1b, u0a, u0b;
            unpack8(*(const u32x4*)(UF + ((size_t)blk * 4 + t) * DM + c8), u2a, u2b);
            if (t == 1) unpack8(*(const u32x4*)(UF + ((size_t)blk * 4 + 0) * DM + c8), u1a, u1b);
            else if (!seq0) unpack8(*(const u32x4*)(UF + ((size_t)(blk - 1) * 4 + 3) * DM + c8), u1a, u1b);
            else if (blk >= NCHUNK_P) { const float* hp = st_conv + ((size_t)(blk - NCHUNK_P) * 2 + 1) * DM + c8; u1a = *(const f32x4*)hp; u1b = *(const f32x4*)(hp + 4); }
            else { u1a = (f32x4){0.f, 0.f, 0.f, 0.f}; u1b = u1a; }
            if (!seq0) unpack8(*(const u32x4*)(UF + ((size_t)(blk - 1) * 4 + 2 + t) * DM + c8), u0a, u0b);
            else if (blk >= NCHUNK_P) { const float* hp = st_conv + ((size_t)(blk - NCHUNK_P) * 2 + t) * DM + c8; u0a = *(const f32x4*)hp; u0b = *(const f32x4*)(hp + 4); }
            else { u0a = (f32x4){0.f, 0.f, 0.f, 0.f}; u0b = u0a; }
            const f32x4 w0a = *(const f32x4*)(conv_w + c8), w0b = *(const f32x4*)(conv_w + c8 + 4);
            const f32x4 w1a = *(const f32x4*)(conv_w + DM + c8), w1b = *(const f32x4*)(conv_w + DM + c8 + 4);
            const f32x4 w2a = *(const f32x4*)(conv_w + 2 * DM + c8), w2b = *(const f32x4*)(conv_w + 2 * DM + c8 + 4);
            f32x4 ga, gb; u32x4* gp = (u32x4*)(GA + (size_t)row * DM + c8); unpack8(*gp, ga, gb);
            *gp = pack8(ga * (w0a * u0a + w1a * u1a + w2a * u2a), gb * (w0b * u0b + w1b * u1b + w2b * u2b));
        }
        for (int it = gt; it < M_TOK * 32; it += NGT) {
            const int row = it >> 5, c8 = (it & 31) * 8;
            const float* pr = (row < MP) ? p_p + (size_t)row * DPLE + c8 : p_s + (size_t)(row - MP) * DPLE + c8;
            *(u32x4*)(PB + (size_t)row * DPLE + c8) = pack8(*(const f32x4*)pr, *(const f32x4*)(pr + 4));
        }
    }

#define LOAD_TILE2(dst, X, un_) do { const int c_ = (un_) >> 3, h_ = (un_) & 7; _Pragma("unroll") for (int i_ = 0; i_ < 2; ++i_) { const int p_ = tid + 512 * i_; \
        dst[i_] = *(const u32x4*)((X) + ((size_t)c_ * 64 + (p_ >> 4)) * DM + h_ * 128 + (p_ & 15) * 8); } } while (0)
#define LOAD_TILE2_NT(dst, X, un_) do { const int c_ = (un_) >> 3, h_ = (un_) & 7; _Pragma("unroll") for (int i_ = 0; i_ < 2; ++i_) { const int p_ = tid + 512 * i_; \
        dst[i_] = __builtin_nontemporal_load((const u32x4*)((X) + ((size_t)c_ * 64 + (p_ >> 4)) * DM + h_ * 128 + (p_ & 15) * 8)); } } while (0)
#define SCATTER_VT(vt_, w_, s_, vg_) do { LAS unsigned short* d_ = (vt_) + ((vg_) * 8) * 72 + VT_GRP((vg_) * 8, (s_) >> 3) + ((s_) & 7); \
        d_[0 * 72] = (unsigned short)((w_).x & 0xffff); d_[1 * 72] = (unsigned short)((w_).x >> 16); d_[2 * 72] = (unsigned short)((w_).y & 0xffff); d_[3 * 72] = (unsigned short)((w_).y >> 16); \
        d_[4 * 72] = (unsigned short)((w_).z & 0xffff); d_[5 * 72] = (unsigned short)((w_).z >> 16); d_[6 * 72] = (unsigned short)((w_).w & 0xffff); d_[7 * 72] = (unsigned short)((w_).w >> 16); } while (0)
    {
        LAS unsigned short* LFb = (LAS unsigned short*)lds;
        LAS unsigned short* kdb = (LAS unsigned short*)(lds + 34816);
        LAS unsigned short* vTb = (LAS unsigned short*)(lds + 71680);
        LAS float* decb = (LAS float*)(lds + 126976);
        const int nsu = (bid < NSU) ? (NSU - bid + G - 1) / G : 0, nps = NSC * nsu;
        const int nst = nps + ((bid < NSMP) ? (NSMP - bid + G - 1) / G : 0);
        u32x4 plf[2], pv[2];
        f32x16 acc0, acc1; float dprod = 1.f;
#pragma unroll
        for (int i = 0; i < 16; ++i) { acc0[i] = 0.f; acc1[i] = 0.f; }
#define P2B_LOAD(j_) do { int un_, su_; bool f_, l_; step_map((j_), nps, bid, G, un_, su_, f_, l_); LOAD_TILE2(plf, LFH, un_); LOAD_TILE2(pv, V, un_); } while (0)
#define P2B_STAGE(j_) do { LAS unsigned short* LF_ = LFb + ((j_) & 1) * (64 * 136); LAS unsigned short* vT_ = vTb + ((j_) % 3) * (128 * 72); \
        _Pragma("unroll") for (int i = 0; i < 2; ++i) { const int p = tid + 512 * i, t = p >> 4, g8 = p & 15; *(LAS u32x4*)(LF_ + t * 136 + g8 * 8) = plf[i]; SCATTER_VT(vT_, pv[i], t, g8); } } while (0)
#define P2B_SCAN(j_) do { int un_, su_; bool f_, l_; step_map((j_), nps, bid, G, un_, su_, f_, l_); \
        p2b_scan(LFb + ((j_) & 1) * (64 * 136), kdb + ((j_) & 1) * (128 * 72), decb + ((j_) & 1) * 128, su_ >= 0 ? DEC + (size_t)su_ * 128 : nullptr, f_, l_, dprod, tid); } while (0)
        if (nst > 0) {
            P2B_LOAD(0); P2B_STAGE(0);
            if (nst > 1) P2B_LOAD(1);
            __syncthreads();
            P2B_SCAN(0);
            if (nst > 1) P2B_STAGE(1);
            if (nst > 2) P2B_LOAD(2);
            __syncthreads();
            for (int j = 0; j < nst; ++j) {
                if (j + 2 < nst) P2B_STAGE(j + 2);
                if (j + 3 < nst) P2B_LOAD(j + 3);
                { int un, su; bool first, last; step_map(j, nps, bid, G, un, su, first, last);
                  p2b_mfma(kdb + (j & 1) * (128 * 72), vTb + (j % 3) * (128 * 72), decb + (j & 1) * 128, un, su, first, last, acc0, acc1, DST, st_hgrn, out + O_HS, wave, lane); }
                if (j + 1 < nst) P2B_SCAN(j + 1);
                __syncthreads();
            }
        }
    }
    GSYNC();

    {
        constexpr int NSQ = NCHUNK_P / NSC / 4;
        for (int it = gt; it < 32 * 4096; it += NGT) {
            const int bh = it >> 12, g4 = it & 4095, b = bh >> 3, h = bh & 7;
            const int v = ((g4 >> 8) & 3) * 32 + (g4 & 31), k0 = (g4 >> 10) * 32 + 8 * ((g4 >> 6) & 3) + 4 * ((g4 >> 5) & 1);
            float S0 = 0.f, S1 = 0.f, S2 = 0.f, S3 = 0.f;
            for (int c0 = 0; c0 < NSQ; c0 += 8) {
                u32x2 ds[8]; f32x4 dc[8];
#pragma unroll
                for (int j = 0; j < 8; ++j) { const size_t su = ((size_t)(b * NSQ + c0 + j)) * 8 + h; ds[j] = *(const u32x2*)(DST + su * 16384 + g4 * 4); dc[j] = *(const f32x4*)(DEC + su * 128 + k0); }
#pragma unroll
                for (int j = 0; j < 8; ++j) { const size_t su = ((size_t)(b * NSQ + c0 + j)) * 8 + h;
                    u32x2 w; w.x = cvt_pk_bf16(S0, S1); w.y = cvt_pk_bf16(S2, S3);
                    *(u32x2*)(DST + su * 16384 + g4 * 4) = w;
                    S0 = dc[j][0] * S0 + bflo(ds[j].x); S1 = dc[j][1] * S1 + bfhi(ds[j].x); S2 = dc[j][2] * S2 + bflo(ds[j].y); S3 = dc[j][3] * S3 + bfhi(ds[j].y); }
            }
            float* so = out + O_HP + (size_t)bh * 16384;
            so[(k0 + 0) * 128 + v] = S0; so[(k0 + 1) * 128 + v] = S1; so[(k0 + 2) * 128 + v] = S2; so[(k0 + 3) * 128 + v] = S3;
        }
    }
    GSYNC();

    {
        LAS unsigned short* LF = (LAS unsigned short*)lds;
        LAS unsigned short* QS = (LAS unsigned short*)(lds + 17408);
        LAS unsigned short* vT = (LAS unsigned short*)(lds + 34816);
        LAS unsigned short* qe = (LAS unsigned short*)(lds + 53248);
        LAS unsigned short* ke = (LAS unsigned short*)(lds + 70656);
        LAS unsigned short* qb = (LAS unsigned short*)(lds + 88064);
        LAS unsigned short* kd = (LAS unsigned short*)(lds + 105472);
        LAS unsigned short* ost = (LAS unsigned short*)(lds + 123904);
        LAS float* qsum = (LAS float*)(lds + 141312);
        LAS float* decs = (LAS float*)(lds + 143360);
        const int nsu = (bid < NSU) ? (NSU - bid + G - 1) / G : 0, nps = NSC * nsu;
        const int nst = nps + ((bid < NSMP) ? (NSMP - bid + G - 1) / G : 0);
        const int tb = wave & 1, vb = wave >> 1, r = lane & 31, hh = lane >> 5;
        u32x4 plf[2], pq[2], pv[2];
        u32x4 sfr[8];
#pragma unroll
        for (int i = 0; i < 8; ++i) sfr[i] = (u32x4){0u, 0u, 0u, 0u};
        if (nst > 0) { int un_, su_; bool f_, l_; step_map(0, nps, bid, G, un_, su_, f_, l_); LOAD_TILE2_NT(plf, LFH, un_); LOAD_TILE2_NT(pq, Q, un_); LOAD_TILE2_NT(pv, V, un_); }
        for (int j = 0; j < nst; ++j) {
            int un, su; bool first, last; step_map(j, nps, bid, G, un, su, first, last);
            const int cidx = un >> 3, h = un & 7; const size_t row0 = (size_t)cidx * 64;
#pragma unroll
            for (int i = 0; i < 2; ++i) { const int p = tid + 512 * i, t = p >> 4, g8 = p & 15;
                *(LAS u32x4*)(LF + t * 136 + g8 * 8) = plf[i]; *(LAS u32x4*)(QS + t * 136 + g8 * 8) = pq[i]; SCATTER_VT(vT, pv[i], t, g8); }
            if (first) {
                if (su >= 0) {
                    const bf16_t* sp = DST + (size_t)su * 16384 + vb * 1024 + launder(lane) * 4;
#pragma unroll
                    for (int kt = 0; kt < 4; ++kt)
#pragma unroll
                        for (int s2 = 0; s2 < 2; ++s2) { const u32x2 lo = *(const u32x2*)(sp + kt * 4096 + (2 * s2) * 256), hi = *(const u32x2*)(sp + kt * 4096 + (2 * s2 + 1) * 256);
                            sfr[kt * 2 + s2] = (u32x4){lo.x, lo.y, hi.x, hi.y}; }
                } else {
                    const float* s0 = st_hgrn + ((size_t)(cidx - NCHUNK_P) * 8 + h) * 16384 + vb * 32 + r;
#pragma unroll
                    for (int f8 = 0; f8 < 8; ++f8) { float sv[8];
#pragma unroll
                        for (int e = 0; e < 8; ++e) sv[e] = s0[(size_t)(16 * f8 + 8 * (e >> 2) + 4 * hh + (e & 3)) * 128];
                        sfr[f8] = (u32x4){cvt_pk_bf16(sv[0], sv[1]), cvt_pk_bf16(sv[2], sv[3]), cvt_pk_bf16(sv[4], sv[5]), cvt_pk_bf16(sv[6], sv[7])}; }
                }
            }
            __syncthreads();
            if (j + 1 < nst) { int un_, su_; bool f_, l_; step_map(j + 1, nps, bid, G, un_, su_, f_, l_); LOAD_TILE2_NT(plf, LFH, un_); LOAD_TILE2_NT(pq, Q, un_); LOAD_TILE2_NT(pv, V, un_); }
            {
                const int k = tid & 127, tq = tid >> 7;
                float fv[16]; float sprod = 1.0f;
#pragma unroll
                for (int jj = 0; jj < 16; ++jj) { fv[jj] = h2f(LF[(tq * 16 + jj) * 136 + k]); sprod *= fv[jj]; }
                qsum[tq * 128 + k] = sprod;
                __syncthreads();
                const float s0q = qsum[k], s1q = qsum[128 + k], s2q = qsum[256 + k], s3q = qsum[384 + k];
                const float eref = s0q * s1q, etot = s2q * s3q, ptot = eref * etot;
                float kv[16];
                float e1 = ((tq > 0 ? s0q : 1.0f) * (tq > 1 ? s1q : 1.0f) * (tq > 2 ? s2q : 1.0f)) * __builtin_amdgcn_rcpf(eref);
#pragma unroll
                for (int jj = 0; jj < 16; ++jj) { const int t = tq * 16 + jj;
                    const float q = silu_f(bf2f(QS[t * 136 + k])) * QK_SCALE;
                    e1 *= fv[jj];
                    const float qev = q * e1;
                    qe[t * 136 + k] = f2bf(qev); qb[t * 136 + k] = f2bf(qev * eref); }
                float rinv1 = __builtin_amdgcn_rcpf(e1);
#pragma unroll
                for (int jj = 15; jj >= 0; --jj) { const int t = tq * 16 + jj;
                    const float kev = (1.0f - fv[jj]) * rinv1;
                    kv[jj] = kev * etot;
                    ke[t * 136 + k] = f2bf(kev);
                    rinv1 *= fv[jj]; }
                u32x4 w0, w1;
                w0.x = cvt_pk_bf16(kv[0], kv[1]); w0.y = cvt_pk_bf16(kv[2], kv[3]); w0.z = cvt_pk_bf16(kv[4], kv[5]); w0.w = cvt_pk_bf16(kv[6], kv[7]);
                w1.x = cvt_pk_bf16(kv[8], kv[9]); w1.y = cvt_pk_bf16(kv[10], kv[11]); w1.z = cvt_pk_bf16(kv[12], kv[13]); w1.w = cvt_pk_bf16(kv[14], kv[15]);
                *(LAS u32x4*)(kd + k * 72 + tq * 16) = w0; *(LAS u32x4*)(kd + k * 72 + tq * 16 + 8) = w1;
                if (tq == 0) decs[k] = ptot;
            }
            __syncthreads();
            f32x16 oacc;
#pragma unroll
            for (int i = 0; i < 16; ++i) oacc[i] = 0.f;
            {
                const LAS unsigned short* qrow = qb + (tb * 32 + r) * 136 + 4 * hh;
#pragma unroll
                for (int kt = 0; kt < 4; ++kt)
#pragma unroll
                    for (int s2 = 0; s2 < 2; ++s2) {
                        const bf16x8 bfr = __builtin_bit_cast(bf16x8, sfr[kt * 2 + s2]);
                        const s16x4 lo = *(const LAS s16x4*)(qrow + 32 * kt + 16 * s2), hi = *(const LAS s16x4*)(qrow + 32 * kt + 16 * s2 + 8);
                        const bf16x8 af = __builtin_shufflevector(lo, hi, 0, 1, 2, 3, 4, 5, 6, 7);
                        oacc = __builtin_amdgcn_mfma_f32_32x32x16_bf16(af, bfr, oacc, 0, 0, 0);
                        if (s2 == 1) __builtin_amdgcn_sched_barrier(0);
                    }
            }
            __builtin_amdgcn_sched_barrier(0);
            const int vrow = vb * 32 + r;
            for (int sb = 0; sb <= tb; ++sb) {
                f32x16 att;
#pragma unroll
                for (int i = 0; i < 16; ++i) att[i] = 0.f;
#pragma unroll
                for (int ks = 0; ks < 8; ++ks) {
                    const bf16x8 af = *(const LAS bf16x8*)(ke + (sb * 32 + r) * 136 + 16 * ks + 8 * hh);
                    const bf16x8 bfr = *(const LAS bf16x8*)(qe + (tb * 32 + r) * 136 + 16 * ks + 8 * hh);
                    att = __builtin_amdgcn_mfma_f32_32x32x16_bf16(af, bfr, att, 0, 0, 0);
                    if (ks & 1) __builtin_amdgcn_sched_barrier(0);
                }
                if (sb == tb) {
#pragma unroll
                    for (int i = 0; i < 16; ++i) { const int sl = (i & 3) + 8 * (i >> 2) + 4 * hh; if (sl > r) att[i] = 0.f; }
                }
#pragma unroll
                for (int s2 = 0; s2 < 2; ++s2) {
                    u32x4 w; w.x = cvt_pk_bf16(att[8 * s2 + 0], att[8 * s2 + 1]); w.y = cvt_pk_bf16(att[8 * s2 + 2], att[8 * s2 + 3]);
                    w.z = cvt_pk_bf16(att[8 * s2 + 4], att[8 * s2 + 5]); w.w = cvt_pk_bf16(att[8 * s2 + 6], att[8 * s2 + 7]);
                    const bf16x8 af = __builtin_bit_cast(bf16x8, w);
                    const LAS unsigned short* vp = vT + vrow * 72 + 4 * hh;
                    const s16x4 lo = *(const LAS s16x4*)(vp + VT_GRP(vrow, sb * 4 + 2 * s2)), hi = *(const LAS s16x4*)(vp + VT_GRP(vrow, sb * 4 + 2 * s2 + 1));
                    const bf16x8 bfr = __builtin_shufflevector(lo, hi, 0, 1, 2, 3, 4, 5, 6, 7);
                    oacc = __builtin_amdgcn_mfma_f32_32x32x16_bf16(af, bfr, oacc, 0, 0, 0);
                }
            }
#pragma unroll
            for (int i = 0; i < 16; ++i) ost[(tb * 32 + (i & 3) + 8 * (i >> 2) + 4 * hh) * 136 + vb * 32 + r] = f2bf(oacc[i]);
            __builtin_amdgcn_sched_barrier(0);
            if (!last) {
#pragma unroll
                for (int kt = 0; kt < 4; ++kt) {
                    f32x16 d;
#pragma unroll
                    for (int s2 = 0; s2 < 2; ++s2) { const u32x4 w = sfr[kt * 2 + s2];
                        d[8 * s2 + 0] = bflo(w.x); d[8 * s2 + 1] = bfhi(w.x); d[8 * s2 + 2] = bflo(w.y); d[8 * s2 + 3] = bfhi(w.y);
                        d[8 * s2 + 4] = bflo(w.z); d[8 * s2 + 5] = bfhi(w.z); d[8 * s2 + 6] = bflo(w.w); d[8 * s2 + 7] = bfhi(w.w); }
#pragma unroll
                    for (int i = 0; i < 16; ++i) d[i] *= decs[kt * 32 + (i & 3) + 8 * (i >> 2) + 4 * hh];
#pragma unroll
                    for (int ks = 0; ks < 4; ++ks) {
                        const bf16x8 af = *(const LAS bf16x8*)(kd + (kt * 32 + r) * 72 + 16 * ks + 8 * hh);
                        const bf16x8 bfr = *(const LAS bf16x8*)(vT + vrow * 72 + VT_GRP(vrow, 2 * ks + hh));
                        d = __builtin_amdgcn_mfma_f32_32x32x16_bf16(af, bfr, d, 0, 0, 0);
                    }
#pragma unroll
                    for (int s2 = 0; s2 < 2; ++s2)
                        sfr[kt * 2 + s2] = (u32x4){cvt_pk_bf16(d[8 * s2 + 0], d[8 * s2 + 1]), cvt_pk_bf16(d[8 * s2 + 2], d[8 * s2 + 3]), cvt_pk_bf16(d[8 * s2 + 4], d[8 * s2 + 5]), cvt_pk_bf16(d[8 * s2 + 6], d[8 * s2 + 7])};
                    __builtin_amdgcn_sched_barrier(0);
                }
            }
            u32x4 psz[2];
            LOAD_TILE2_NT(psz, SZ, un);
            __syncthreads();
#pragma unroll
            for (int i = 0; i < 2; ++i) { const int p = tid + 512 * i, t = p >> 4, vg = p & 15;
                f32x4 o0, o1, z0, z1; unpack8(*(const LAS u32x4*)(ost + t * 136 + vg * 8), o0, o1);
                float ss = (o0[0] * o0[0] + o0[1] * o0[1]) + (o0[2] * o0[2] + o0[3] * o0[3]) + (o1[0] * o1[0] + o1[1] * o1[1]) + (o1[2] * o1[2] + o1[3] * o1[3]);
                ss += __shfl_xor(ss, 1); ss += __shfl_xor(ss, 2); ss += __shfl_xor(ss, 4); ss += __shfl_xor(ss, 8);
                const float rs = rsqrtf(ss * (1.0f / 128.0f) + EPS);
                unpack8(psz[i], z0, z1);
#pragma unroll
                for (int e = 0; e < 4; ++e) { z0[e] = silu_f(z0[e]); z1[e] = silu_f(z1[e]); }
                *(u32x4*)(SZ + (row0 + t) * DM + h * 128 + vg * 8) = pack8(o0 * rs * z0, o1 * rs * z1);
                __builtin_amdgcn_sched_barrier(0); }
        }
        __syncthreads();
    }
    GSYNC();

    {
        { pg8::Gemm g{GA, SZ, BTAB, MP, DM, 2048, DM, 2048, 16}; pg8::StaticOrder S; S.init(MP, DM, G, bid);
          EpiMerge E{SGA, SGB, MG};
          pg8::gemm_phase<EpiMerge, true, true>(lds, g, S, E); }
        { pg8::Gemm gp{PB, nullptr, BTP, MP, DM, DPLE, DPLE, DPLE, 0}; pg8::StaticOrder S2; S2.init(MP, DM, G, bid);
          EpiPP E2{PP}; pg8::gemm_phase<EpiPP, true, true>(lds, gp, S2, E2); }
        for (int tile = bid; tile < 256; tile += G) {
            const int tr = tile >> 3, tc = tile & 7, rbase = MP + tr * 64, cbase = tc * 128;
            const int wr2 = wave >> 2, wc4 = wave & 3, r = lane & 31, hh = lane >> 5;
            const int col = cbase + wc4 * 32 + r;
            {
                f32x16 accP;
#pragma unroll
                for (int i = 0; i < 16; ++i) accP[i] = 0.f;
                accP = mini_gemm(lds, PB + (size_t)rbase * DPLE, DPLE, BTP + (size_t)cbase * DPLE, DPLE, DPLE, tid, wave, lane, accP);
#pragma unroll
                for (int i = 0; i < 16; ++i) { const int row = rbase + wr2 * 32 + (i & 3) + 8 * (i >> 2) + 4 * hh; PP[(size_t)row * DM + col] = f2bf(accP[i]); }
            }
            f32x16 accA, accB;
#pragma unroll
            for (int i = 0; i < 16; ++i) { accA[i] = 0.f; accB[i] = 0.f; }
            accA = mini_gemm(lds, GA + (size_t)rbase * DM, DM, BTAB + (size_t)cbase * 2048, 2048, DM, tid, wave, lane, accA);
            accB = mini_gemm(lds, SZ + (size_t)rbase * DM, DM, BTAB + (size_t)cbase * 2048 + 1024, 2048, DM, tid, wave, lane, accB);
            float ga[16], gb[16];
#pragma unroll
            for (int i = 0; i < 16; ++i) { const int row = rbase + wr2 * 32 + (i & 3) + 8 * (i >> 2) + 4 * hh; const size_t off = (size_t)row * DM + col;
                ga[i] = bf2f(SGA[off]); gb[i] = bf2f(SGB[off]); }
#pragma unroll
            for (int i = 0; i < 16; ++i) { const int row = rbase + wr2 * 32 + (i & 3) + 8 * (i >> 2) + 4 * hh; const size_t off = (size_t)row * DM + col;
                MG[off] = f2bf(ga[i] * accA[i] + gb[i] * accB[i]); }
        }
    }
    GSYNC();

    {
        { pg8::Gemm g{MG, nullptr, BTO, MP, DM, DM, DM, DM, 0}; pg8::StaticOrder S; S.init(MP, DM, G, bid);
          EpiO E{OUTB, SSQ};
          pg8::gemm_phase<EpiO, true, true>(lds, g, S, E); }
        for (int tile = bid; tile < 256; tile += G) {
            const int tr = tile >> 3, tc = tile & 7, rbase = MP + tr * 64, cbase = tc * 128;
            const int wr2 = wave >> 2, wc4 = wave & 3, r = lane & 31, hh = lane >> 5;
            const int col = cbase + wc4 * 32 + r;
            f32x16 acc;
#pragma unroll
            for (int i = 0; i < 16; ++i) acc[i] = 0.f;
            acc = mini_gemm(lds, MG + (size_t)rbase * DM, DM, BTO + (size_t)cbase * DM, DM, DM, tid, wave, lane, acc);
#pragma unroll
            for (int i = 0; i < 16; ++i) { const int row = rbase + wr2 * 32 + (i & 3) + 8 * (i >> 2) + 4 * hh;
                OUTB[(size_t)row * DM + col] = f2bf(acc[i]);
                float s = acc[i] * acc[i];
                s += __shfl_xor(s, 1); s += __shfl_xor(s, 2); s += __shfl_xor(s, 4); s += __shfl_xor(s, 8); s += __shfl_xor(s, 16);
                if (r == 0) SSQ2[(size_t)(row - MP) * 32 + tc * 4 + wc4] = s; }
        }
    }
    GSYNC();

    {
        const f32x4* gr = (const f32x4*)g_post + lane;
        f32x4 gp[4];
#pragma unroll
        for (int j = 0; j < 4; ++j) gp[j] = gr[64 * j];
        for (int m0 = gw; m0 < M_TOK; m0 += 2 * NGW) {
            const int m1 = m0 + NGW; const bool has1 = m1 < M_TOK; const int m1c = has1 ? m1 : m0;
            const f32x4* xr0 = (const f32x4*)((m0 < MP) ? x_p + (size_t)m0 * DM : x_s + (size_t)(m0 - MP) * DM) + lane;
            const f32x4* xr1 = (const f32x4*)((m1c < MP) ? x_p + (size_t)m1c * DM : x_s + (size_t)(m1c - MP) * DM) + lane;
            const u32x2* or0 = (const u32x2*)(OUTB + (size_t)m0 * DM) + lane; const u32x2* or1 = (const u32x2*)(OUTB + (size_t)m1c * DM) + lane;
            float sq0 = (m0 < MP) ? ((lane < 16) ? SSQ[(size_t)m0 * 16 + lane] : 0.f) : ((lane < 32) ? SSQ2[(size_t)(m0 - MP) * 32 + lane] : 0.f);
            float sq1 = (m1c < MP) ? ((lane < 16) ? SSQ[(size_t)m1c * 16 + lane] : 0.f) : ((lane < 32) ? SSQ2[(size_t)(m1c - MP) * 32 + lane] : 0.f);
            f32x4 x0[4], x1[4]; u32x2 w0[4], w1[4];
#pragma unroll
            for (int j = 0; j < 4; ++j) { x0[j] = xr0[64 * j]; x1[j] = xr1[64 * j]; w0[j] = or0[64 * j]; w1[j] = or1[64 * j]; }
            sq0 = wave_sum(sq0); sq1 = wave_sum(sq1);
            const float rs0 = rsqrtf(sq0 * (1.0f / DM) + EPS), rs1 = rsqrtf(sq1 * (1.0f / DM) + EPS);
            float s0 = 0.f, s1 = 0.f;
#pragma unroll
            for (int j = 0; j < 4; ++j) {
                const f32x4 of0 = (f32x4){bflo(w0[j].x), bfhi(w0[j].x), bflo(w0[j].y), bfhi(w0[j].y)}, of1 = (f32x4){bflo(w1[j].x), bfhi(w1[j].x), bflo(w1[j].y), bfhi(w1[j].y)};
                x0[j] = x0[j] + of0 * rs0 * gp[j]; x1[j] = x1[j] + of1 * rs1 * gp[j];
                s0 += (x0[j][0] * x0[j][0] + x0[j][1] * x0[j][1]) + (x0[j][2] * x0[j][2] + x0[j][3] * x0[j][3]);
                s1 += (x1[j][0] * x1[j][0] + x1[j][1] * x1[j][1]) + (x1[j][2] * x1[j][2] + x1[j][3] * x1[j][3]); }
            s0 = wave_sum(s0); s1 = wave_sum(s1);
            if (lane == 0) { R1[m0] = rsqrtf(s0 * (1.0f / DM) + EPS); RINV[m0] = rs0; if (has1) { R1[m1] = rsqrtf(s1 * (1.0f / DM) + EPS); RINV[m1] = rs1; } }
            f32x4* y0 = (f32x4*)(out + O_Y + (size_t)m0 * DM) + lane; u32x2* b0 = (u32x2*)(X1B + (size_t)m0 * DM) + lane;
#pragma unroll
            for (int j = 0; j < 4; ++j) { if (m0 >= MP) y0[64 * j] = x0[j];
                u32x2 w; w.x = cvt_pk_bf16(x0[j][0], x0[j][1]); w.y = cvt_pk_bf16(x0[j][2], x0[j][3]); b0[64 * j] = w; }
            if (has1) {
                f32x4* y1 = (f32x4*)(out + O_Y + (size_t)m1 * DM) + lane; u32x2* b1 = (u32x2*)(X1B + (size_t)m1 * DM) + lane;
#pragma unroll
                for (int j = 0; j < 4; ++j) { if (m1 >= MP) y1[64 * j] = x1[j];
                    u32x2 w; w.x = cvt_pk_bf16(x1[j][0], x1[j][1]); w.y = cvt_pk_bf16(x1[j][2], x1[j][3]); b1[64 * j] = w; }
            }
        }
    }
    GSYNC();

    {
        pg8::StaticOrder S; S.init(M_TOK, DM, G, bid);
        { pg8::Gemm g{X1B, nullptr, BTG, MP, DM, DM, DM, DM, 0}; pg8::StaticOrder Sp; Sp.init(MP, DM, G, bid); EpiFinal E{R1, RINV  , PP, OUTB, x_p, g_post, out + O_Y}; pg8::gemm_phase<EpiFinal, true, true>(lds, g, Sp, E); }
        for (int tile = bid; tile < 256; tile += G) {
            const int tr = tile >> 3, tc = tile & 7, rbase = MP + tr * 64, cbase = tc * 128;
            f32x16 acc;
#pragma unroll
            for (int i = 0; i < 16; ++i) acc[i] = 0.f;
            acc = mini_gemm(lds, X1B + (size_t)rbase * DM, DM, BTG + (size_t)cbase * DM, DM, DM, tid, wave, lane, acc);
            const int wr2 = wave >> 2, wc4 = wave & 3, r = lane & 31, hh = lane >> 5;
            const int col = cbase + wc4 * 32 + r;
            float yv[16], pv2[16], rv[16];
#pragma unroll
            for (int i = 0; i < 16; ++i) { const int row = rbase + wr2 * 32 + (i & 3) + 8 * (i >> 2) + 4 * hh; const size_t off = (size_t)row * DM + col;
                yv[i] = out[O_Y + off]; pv2[i] = bf2f(PP[off]); rv[i] = R1[row]; }
#pragma unroll
            for (int i = 0; i < 16; ++i) { const int row = rbase + wr2 * 32 + (i & 3) + 8 * (i >> 2) + 4 * hh; const size_t off = (size_t)row * DM + col;
                out[O_Y + off] = yv[i] + pv2[i] * sigmoid_f(acc[i] * rv[i]); }
        }
    }
}

extern "C" void kernel_launch(void* const* d_in, const int* in_sizes, int n_in, void* d_out, int out_size, void* d_ws, size_t ws_size, hipStream_t stream) {
    static int grid_blocks = 0;
    if (grid_blocks == 0) {
        if (n_in != 18 || (size_t)out_size != O_TOTAL || ws_size < WS_END) { fprintf(stderr, "kernel_launch: unexpected shapes (n_in %d out %d ws %zu)\n", n_in, out_size, ws_size); grid_blocks = -1; return; }
        int dev = 0, cus = 0, per_cu = 0;
        hipGetDevice(&dev);
        hipDeviceGetAttribute(&cus, hipDeviceAttributeMultiprocessorCount, dev);
        hipFuncSetAttribute((const void*)fwd_kernel, hipFuncAttributeMaxDynamicSharedMemorySize, LDS_BYTES);
        hipOccupancyMaxActiveBlocksPerMultiprocessor(&per_cu, (const void*)fwd_kernel, 512, LDS_BYTES);
        if (per_cu < 1) { fprintf(stderr, "kernel_launch: occupancy query says %d blocks per CU\n", per_cu); grid_blocks = -1; return; }
        grid_blocks = cus * per_cu;
    }
    if (grid_blocks < 0) return;
    if (hipMemsetAsync((char*)d_ws + WS_BAR, 0, XCD_BAR_WORDS * 4, stream) != hipSuccess) { fprintf(stderr, "kernel_launch: memset of barrier words failed\n"); return; }
    Args a{};
    for (int i = 0; i < 18; ++i) a.in[i] = (const float*)d_in[i];
    a.out = (float*)d_out; a.ws = (unsigned char*)d_ws;
    void* args[] = {&a};
    hipError_t e = hipLaunchCooperativeKernel((const void*)fwd_kernel, dim3(grid_blocks), dim3(512), args, LDS_BYTES, stream);
    if (e != hipSuccess) fprintf(stderr, "cooperative launch failed: %s (grid %d)\n", hipGetErrorString(e), grid_blocks);
}
```
